# Optimizing an MI355X kernel written in HIP

```python
import jax, jax.numpy as jnp
from jax import lax
import numpy as np


D_MODEL = 2048
BATCH = 16
SEQ = 2048
DEPTH = 4

N_A_LAYERS = DEPTH // 2
N_B_LAYERS = DEPTH - N_A_LAYERS
HEAD_DIM = 128
N_MIX_HEADS = D_MODEL // HEAD_DIM
MEM_HEADS = 4
SB_HEADS = N_MIX_HEADS - MEM_HEADS
MLA_HEADS = N_MIX_HEADS - MEM_HEADS
MLA_NOPE_DIM = 128
MLA_ROPE_DIM = 64
MLA_V_DIM = 128
Q_LORA_RANK = 512
KV_LORA_RANK = 512
MEM_LEN = 256
FFN_HIDDEN = -(-8 * D_MODEL // (3 * 256)) * 256
BLOCK_Q = 128
ROPE_THETA = 10000.0
RMS_EPS = 1e-6

A_IN_WIDTH = 3 * SB_HEADS * HEAD_DIM + MEM_HEADS * HEAD_DIM
B_IN_WIDTH = Q_LORA_RANK + MEM_HEADS * HEAD_DIM
A_OUT_WIDTH = SB_HEADS * HEAD_DIM + MEM_HEADS * HEAD_DIM
B_OUT_WIDTH = MLA_HEADS * MLA_V_DIM + MEM_HEADS * HEAD_DIM

kernel_name = "yoco_stickbreak_mla_hybrid"


def rmsnorm(x, g):
    x32 = x.astype(jnp.float32)
    y = x32 * lax.rsqrt(jnp.mean(x32 * x32, axis=-1, keepdims=True) + RMS_EPS)
    return y.astype(x.dtype) * g


def rope_tables(positions, dtype):
    half = MLA_ROPE_DIM // 2
    inv_freq = ROPE_THETA ** (-jnp.arange(half, dtype=jnp.float32) / half)
    ang = positions.astype(jnp.float32)[..., None] * inv_freq
    return jnp.cos(ang).astype(dtype), jnp.sin(ang).astype(dtype)


def apply_rope(x, cos, sin):
    half = x.shape[-1] // 2
    x1, x2 = x[..., :half], x[..., half:]
    return jnp.concatenate([x1 * cos - x2 * sin, x2 * cos + x1 * sin], axis=-1)


def to_query_blocks(t):
    b, s, h, d = t.shape
    return t.reshape(b, s // BLOCK_Q, BLOCK_Q, h, d).transpose(1, 0, 3, 2, 4)


def from_query_blocks(t):
    nb, b, h, bq, d = t.shape
    return t.transpose(1, 0, 3, 2, 4).reshape(b, nb * bq, h * d)


def stick_breaking_attention(q, k, v):
    seq = q.shape[1]
    scale = q.shape[-1] ** -0.5
    kh = k.transpose(0, 2, 1, 3)
    vh = v.transpose(0, 2, 1, 3)
    key_pos = jnp.arange(seq)
    starts = jnp.arange(seq // BLOCK_Q) * BLOCK_Q

    def one_block(args):
        q_blk, start = args
        z = jnp.einsum("bhqd,bhkd->bhqk", q_blk, kh).astype(jnp.float32) * scale
        query_pos = start + jnp.arange(BLOCK_Q)
        strictly_past = key_pos[None, :] < query_pos[:, None]
        log_keep = jnp.where(strictly_past, -jax.nn.softplus(z), 0.0)
        log_stick = lax.cumsum(log_keep, axis=3, reverse=True) - log_keep
        w = jnp.where(strictly_past, jnp.exp(jax.nn.log_sigmoid(z) + log_stick), 0.0)
        return jnp.einsum("bhqk,bhkd->bhqd", w.astype(vh.dtype), vh)

    out = lax.map(one_block, (to_query_blocks(q), starts))
    return from_query_blocks(out)


def mla_attention(q_nope, q_rope, k_nope, k_rope, v):
    seq = q_nope.shape[1]
    scale = (MLA_NOPE_DIM + MLA_ROPE_DIM) ** -0.5
    knh = k_nope.transpose(0, 2, 1, 3)
    vh = v.transpose(0, 2, 1, 3)
    key_pos = jnp.arange(seq)
    starts = jnp.arange(seq // BLOCK_Q) * BLOCK_Q

    def one_block(args):
        qn, qr, start = args
        s = (jnp.einsum("bhqd,bhkd->bhqk", qn, knh)
             + jnp.einsum("bhqr,bkr->bhqk", qr, k_rope)).astype(jnp.float32) * scale
        causal = key_pos[None, :] <= (start + jnp.arange(BLOCK_Q))[:, None]
        p = jax.nn.softmax(jnp.where(causal, s, -jnp.inf), axis=-1)
        return jnp.einsum("bhqk,bhkd->bhqd", p.astype(vh.dtype), vh)

    out = lax.map(one_block, (to_query_blocks(q_nope), to_query_blocks(q_rope), starts))
    return from_query_blocks(out)


def memory_attention(q, k, v):
    b, s, hm, d = q.shape
    sc = jnp.einsum("bshd,bmhd->bhsm", q, k).astype(jnp.float32) * d ** -0.5
    p = jax.nn.softmax(sc, axis=-1)
    o = jnp.einsum("bhsm,bmhd->bshd", p.astype(v.dtype), v)
    return o.reshape(b, s, hm * d)


def swiglu(x, w_gate_up, w_down):
    gate, up = jnp.split(x @ w_gate_up, 2, axis=-1)
    return (jax.nn.silu(gate) * up) @ w_down


def shared_latent_kv(h, kv_norm_g, w_dkv, kv_latent_g, w_ukv, cos, sin):
    b, s, _ = h.shape
    ckv = rmsnorm(h, kv_norm_g) @ w_dkv
    c_latent = rmsnorm(ckv[..., :KV_LORA_RANK], kv_latent_g)
    k_rope = apply_rope(ckv[..., KV_LORA_RANK:], cos, sin)
    kv = (c_latent @ w_ukv).reshape(b, s, MLA_HEADS, MLA_NOPE_DIM + MLA_V_DIM)
    return kv[..., :MLA_NOPE_DIM], k_rope, kv[..., MLA_NOPE_DIM:]


def setup_inputs(seed: int = 0) -> dict:
    key = jax.random.key(seed)
    ks = jax.random.split(key, 24)

    def dense(k, shape):
        return jax.random.normal(k, shape, jnp.float32) * shape[-2] ** -0.5

    def gain(k, shape):
        return 1.0 + 0.02 * jax.random.normal(k, shape, jnp.float32)

    start = jax.random.randint(ks[2], (BATCH, 1), 0, 4096, dtype=jnp.int32)
    positions = start + jnp.arange(SEQ, dtype=jnp.int32)[None, :]
    return {
        "x": jax.random.normal(ks[0], (BATCH, SEQ, D_MODEL), jnp.float32),
        "mem": jax.random.normal(ks[1], (BATCH, MEM_LEN, D_MODEL), jnp.float32),
        "positions": positions,
        "attn_norm_g": gain(ks[3], (DEPTH, D_MODEL)),
        "ffn_norm_g": gain(ks[4], (DEPTH, D_MODEL)),
        "a_w_in": dense(ks[5], (N_A_LAYERS, D_MODEL, A_IN_WIDTH)),
        "a_w_out": dense(ks[6], (N_A_LAYERS, A_OUT_WIDTH, D_MODEL)),
        "b_w_in": dense(ks[7], (N_B_LAYERS, D_MODEL, B_IN_WIDTH)),
        "b_q_norm_g": gain(ks[8], (N_B_LAYERS, Q_LORA_RANK)),
        "b_w_uq": dense(ks[9], (N_B_LAYERS, Q_LORA_RANK, MLA_HEADS * (MLA_NOPE_DIM + MLA_ROPE_DIM))),
        "b_w_out": dense(ks[10], (N_B_LAYERS, B_OUT_WIDTH, D_MODEL)),
        "mem_norm_g": gain(ks[11], (D_MODEL,)),
        "w_mem_kv": dense(ks[12], (DEPTH, D_MODEL, 2 * MEM_HEADS * HEAD_DIM)),
        "kv_norm_g": gain(ks[13], (D_MODEL,)),
        "w_dkv": dense(ks[14], (D_MODEL, KV_LORA_RANK + MLA_ROPE_DIM)),
        "kv_latent_g": gain(ks[15], (KV_LORA_RANK,)),
        "w_ukv": dense(ks[16], (KV_LORA_RANK, MLA_HEADS * (MLA_NOPE_DIM + MLA_V_DIM))),
        "ffn_w_gu": dense(ks[17], (DEPTH, D_MODEL, 2 * FFN_HIDDEN)),
        "ffn_w_down": dense(ks[18], (DEPTH, FFN_HIDDEN, D_MODEL)),
        "final_norm_g": gain(ks[19], (D_MODEL,)),
    }


def reference(x, mem, positions, attn_norm_g, ffn_norm_g, a_w_in, a_w_out, b_w_in,
              b_q_norm_g, b_w_uq, b_w_out, mem_norm_g, w_mem_kv, kv_norm_g, w_dkv,
              kv_latent_g, w_ukv, ffn_w_gu, ffn_w_down, final_norm_g):
    b, s, _ = x.shape
    cos, sin = rope_tables(positions, x.dtype)
    mem_n = rmsnorm(mem, mem_norm_g)
    sb_w = SB_HEADS * HEAD_DIM
    mq_w = MEM_HEADS * HEAD_DIM
    h = x
    for layer in range(DEPTH):
        if layer == N_A_LAYERS:
            k_nope, k_rope, v_lat = shared_latent_kv(h, kv_norm_g, w_dkv, kv_latent_g, w_ukv, cos, sin)
        xn = rmsnorm(h, attn_norm_g[layer])
        mkv = (mem_n @ w_mem_kv[layer]).reshape(b, MEM_LEN, 2, MEM_HEADS, HEAD_DIM)
        if layer < N_A_LAYERS:
            proj = xn @ a_w_in[layer]
            q = proj[..., :sb_w].reshape(b, s, SB_HEADS, HEAD_DIM)
            k = proj[..., sb_w:2 * sb_w].reshape(b, s, SB_HEADS, HEAD_DIM)
            v = proj[..., 2 * sb_w:3 * sb_w].reshape(b, s, SB_HEADS, HEAD_DIM)
            q_mem = proj[..., 3 * sb_w:].reshape(b, s, MEM_HEADS, HEAD_DIM)
            mix = stick_breaking_attention(q, k, v)
            w_out = a_w_out[layer]
        else:
            i = layer - N_A_LAYERS
            proj = xn @ b_w_in[i]
            c_q = rmsnorm(proj[..., :Q_LORA_RANK], b_q_norm_g[i])
            q_mem = proj[..., Q_LORA_RANK:].reshape(b, s, MEM_HEADS, HEAD_DIM)
            q = (c_q @ b_w_uq[i]).reshape(b, s, MLA_HEADS, MLA_NOPE_DIM + MLA_ROPE_DIM)
            q_rope = apply_rope(q[..., MLA_NOPE_DIM:], cos[:, :, None, :], sin[:, :, None, :])
            mix = mla_attention(q[..., :MLA_NOPE_DIM], q_rope, k_nope, k_rope, v_lat)
            w_out = b_w_out[i]
        mem_out = memory_attention(q_mem, mkv[:, :, 0], mkv[:, :, 1])
        h = h + jnp.concatenate([mix, mem_out], axis=-1) @ w_out
        h = h + swiglu(rmsnorm(h, ffn_norm_g[layer]), ffn_w_gu[layer], ffn_w_down[layer])
    return rmsnorm(h, final_norm_g)
```

```cpp
#include <hip/hip_runtime.h>
#include <cstdio>
#include <cstdint>

#ifndef MK_PER_PHASE
#define MK_PER_PHASE 0
#endif

#ifndef PROBE_ATT
#define PROBE_ATT 1
#endif
#ifndef PROBE_ATT_MAIN
#define PROBE_ATT_MAIN 1
#endif
#ifndef PROBE_ATT_MEM
#define PROBE_ATT_MEM 1
#endif
#ifndef PROBE_GU
#define PROBE_GU 1
#endif
#ifndef PROBE_PRO
#define PROBE_PRO 1
#endif
#ifndef PROBE_EPI
#define PROBE_EPI 1
#endif
#ifndef PROBE_NULL_DN
#define PROBE_NULL_DN 0
#endif
#ifndef PROBE_NULL_OUT
#define PROBE_NULL_OUT 0
#endif
#ifndef PROBE_NULL_AIN
#define PROBE_NULL_AIN 0
#endif
#ifndef PROBE_NULL_B
#define PROBE_NULL_B 0
#endif
#ifndef PROBE_EPI_WHICH
#define PROBE_EPI_WHICH 0
#endif
#ifndef PROBE_SPLIT_GU
#define PROBE_SPLIT_GU 0
#endif
#define LAS __attribute__((address_space(3)))
#define GAS __attribute__((address_space(1)))
typedef unsigned short bf16_t;
typedef short bf16x8 __attribute__((ext_vector_type(8)));
typedef short s16x4 __attribute__((ext_vector_type(4)));
typedef float f32x4 __attribute__((ext_vector_type(4)));
typedef float f32x16 __attribute__((ext_vector_type(16)));
typedef unsigned u32x4 __attribute__((ext_vector_type(4)));
typedef unsigned u32x2 __attribute__((ext_vector_type(2)));

constexpr int BATCH = 16, SEQ = 2048, DM = 2048, M = BATCH * SEQ;
constexpr int NH = 12, HD = 128, MEMH = 4, MEML = 256, MROWS = BATCH * MEML;
constexpr int FFN = 5632;
constexpr int A_IN = 5120, PB_LD = 1792, UQ_N = 2304, UKV_N = 3072, KVLD = 3072;
constexpr float RMS_EPS = 1e-6f;

constexpr size_t MiB = 1u << 20;
constexpr size_t WS_CTL = 0, CTL_ZERO_BYTES = 64 * 1024;
constexpr size_t WS_SS = 1 * MiB;
constexpr size_t WS_SSQ = 5 * MiB;
constexpr size_t WS_SSL = 6 * MiB;
constexpr size_t WS_COS = 7 * MiB;
constexpr size_t WS_SIN = 11 * MiB;
constexpr size_t WS_HB = 16 * MiB;
constexpr size_t WS_KV = 144 * MiB;
constexpr size_t WS_KR = 336 * MiB;
constexpr size_t WS_MEMKV = 340 * MiB;
constexpr size_t WS_MEMN = 372 * MiB;
constexpr size_t WS_BIG = 388 * MiB;
constexpr size_t WS_PROJ = WS_BIG;
constexpr size_t WS_PB = WS_BIG;
constexpr size_t WS_Q = WS_BIG + 112 * MiB;
constexpr size_t WS_MIX = WS_BIG + 320 * MiB;
constexpr size_t WS_HID = WS_BIG;
constexpr size_t WS_W = 836 * MiB;
constexpr size_t W_AIN = WS_W;
constexpr size_t W_AOUT = W_AIN + 40 * MiB;
constexpr size_t W_BIN = W_AOUT + 16 * MiB;
constexpr size_t W_UQ = W_BIN + 14 * MiB;
constexpr size_t W_BOUT = W_UQ + 5 * MiB;
constexpr size_t W_MEMKV = W_BOUT + 16 * MiB;
constexpr size_t W_UKV = W_MEMKV + 16 * MiB;
constexpr size_t W_GU = W_UKV + 3 * MiB;
constexpr size_t W_DN = W_GU + 176 * MiB;
constexpr size_t WS_END = W_DN + 88 * MiB;
static_assert(WS_HID + (size_t)M * FFN * 2 <= WS_W && WS_MIX + (size_t)M * DM * 2 <= WS_W, "ws map");
constexpr int CW_BAR = 4096;

constexpr int RING_BYTES = 131072;
constexpr int LDSCTL_OFF = RING_BYTES, MISC_OFF = LDSCTL_OFF + 320;
constexpr int LDS_BYTES = 155648;

__device__ __forceinline__ unsigned f2bf(float f) { unsigned u = __builtin_bit_cast(unsigned, f); return (u + 0x7fffu + ((u >> 16) & 1u)) >> 16; }
__device__ __forceinline__ unsigned pk2(float lo, float hi) { return f2bf(lo) | (f2bf(hi) << 16); }
__device__ __forceinline__ unsigned cvt_pk_bf16(float lo, float hi) { unsigned r; asm volatile("v_cvt_pk_bf16_f32 %0, %1, %2" : "=v"(r) : "v"(lo), "v"(hi)); return r; }
__device__ __forceinline__ int lane_id() { int l; asm volatile("v_mbcnt_lo_u32_b32 %0, -1, 0\n\tv_mbcnt_hi_u32_b32 %0, -1, %0" : "=v"(l)); return l; }
#define MY_TID(wave_) (((wave_) << 6) | lane_id())
__device__ __forceinline__ float wave_sum(float v) {
#pragma unroll
    for (int o = 1; o < 64; o <<= 1) v += __shfl_xor(v, o);
    return v;
}

namespace pg8 {
constexpr int BM = 256, BK = 64, HALF = 128, HTB = HALF * BK * 2, STAGE_BYTES = 8 * HTB, NXCD = 8, WGM = 4;
__host__ __device__ __forceinline__ int lds_byte(int r, int c) { const int st = (r >> 4) * 2 + (c >> 5), rr = r & 15, cc = c & 31, ob = rr * 64 + cc * 2; return st * 1024 + (ob ^ (((ob >> 9) & 1) << 5)); }
__host__ __device__ __forceinline__ void stage_rc(int b, int& R, int& C) { const int st = b / 1024, sb = b % 1024, swz = sb ^ (((sb >> 9) & 1) << 5); R = (st >> 1) * 16 + swz / 64; C = (st & 1) * 32 + (swz % 64) / 2; }
__host__ __device__ __forceinline__ int perm32(int rho) { const int n = rho >> 4, i = rho & 15; return 8 * (i >> 2) + 4 * n + (i & 3); }

struct Unit { int pm, pn; };
struct Gemm { const bf16_t* A; const bf16_t* Bt; int M, N, K, lda, ldb; };

struct StaticOrder {
    int nM, nN, nwg, G, c;
    struct Pos { int L, gid, rem; };
    __device__ bool step(Pos& p, Unit& u) const {
        p.L += G; if (p.L >= nwg) return false;
        const int nig = WGM * nN; p.rem += G >> 3;
        while (p.rem >= nig) { p.rem -= nig; ++p.gid; }
        u.pm = p.gid * WGM + (p.rem & (WGM - 1)); u.pn = p.rem / WGM; return true;
    }
    __device__ bool first(Pos& p, Unit& u) const {
        p.L = c; if (p.L >= nwg) return false;
        const int wgid = (p.L & 7) * (nwg >> 3) + (p.L >> 3), nig = WGM * nN;
        p.gid = wgid / nig; p.rem = wgid - p.gid * nig;
        u.pm = p.gid * WGM + (p.rem & (WGM - 1)); u.pn = p.rem / WGM; return true;
    }
    __device__ void init(int M_, int N_, int G_, int c_) { nM = M_ / BM; nN = N_ / BM; nwg = nM * nN; G = G_; c = c_; }
    __device__ bool next(int i, Unit& u) const {
        const long L = (long)i * G + c; if (L >= nwg) return false;
        int wgid = (int)L; { const int q = nwg / NXCD, r = nwg % NXCD, xcd = wgid % NXCD, off = wgid / NXCD; wgid = (xcd < r ? xcd * (q + 1) : r * (q + 1) + (xcd - r) * q) + off; }
        const int nig = WGM * nN, gid = wgid / nig, fm = gid * WGM, gsz = (nM - fm) < WGM ? (nM - fm) : WGM;
        u.pm = fm + ((wgid % nig) % gsz); u.pn = (wgid % nig) / gsz; return true;
    }
};

__device__ __forceinline__ const char* uptr(const char* p) {
    const unsigned long long v = (unsigned long long)p;
    const unsigned lo = (unsigned)__builtin_amdgcn_readfirstlane((int)(unsigned)v), hi = (unsigned)__builtin_amdgcn_readfirstlane((int)(unsigned)(v >> 32));
    return (const char*)(((unsigned long long)hi << 32) | lo);
}
template <int OFF> __device__ __forceinline__ f32x4 lds_rd128f(int addr) { f32x4 r; asm volatile("ds_read_b128 %0, %1 offset:%2" : "=&v"(r) : "v"(addr), "i"(OFF) : "memory"); return r; }
template <class Epi>
__device__ __forceinline__ void gemm_phase(LAS unsigned char* lds, const Gemm g, const StaticOrder& S, const Epi& E, const int wave) {
    int tid_ = MY_TID(wave); asm volatile("" : "+v"(tid_));
    const int tid = tid_, wid = __builtin_amdgcn_readfirstlane(tid >> 6), lane = tid & 63, wr = wid >> 2, wc = wid & 3, fr = lane & 15, fq = lane >> 4;
    const int K = g.K, nt = K / BK;
    unsigned voffA[2], voffB[2];
#pragma unroll
    for (int i = 0; i < 2; ++i) { int R, C; stage_rc(tid * 16 + i * 8192, R, C); const int Rb = (R & ~31) + perm32(R & 31);
        voffA[i] = (unsigned)(R * g.lda + C) * 2u; voffB[i] = (unsigned)(Rb * g.ldb + C) * 2u; }
    const size_t kstep = (size_t)(BK * 2);
    const size_t hstepA = (size_t)HALF * g.lda * 2, hstepB = (size_t)HALF * g.ldb * 2;
    const size_t tstepA = 2 * hstepA, tstepB = 2 * hstepB;
    const unsigned ldsw = (unsigned)wid * 1024u;
    const int aoff = lds_byte(wr * 64 + fr, fq * 8), boff = lds_byte(wc * 32 + fr, fq * 8);
#define PG8_SA(b, h) (((b) * 2 + (h)) * HTB)
#define PG8_SB(b, h) ((4 + (b) * 2 + (h)) * HTB)
#define PG8_STAGE(bufoff, gbase, voff) do { const char* gb__ = uptr((const char*)(gbase)); _Pragma("unroll") for (int _i = 0; _i < 2; ++_i) { asm volatile("" : "+v"((voff)[_i])); \
        __builtin_amdgcn_global_load_lds((const unsigned*)(gb__ + (voff)[_i]), (LAS unsigned*)(lds + (bufoff) + ldsw + _i * 8192), 16, 0, 0); } } while (0)
#define PG8_LDA(dst, b, h) do { _Pragma("unroll") for (int m = 0; m < 4; ++m) _Pragma("unroll") for (int k = 0; k < 2; ++k) dst[m][k] = *(const LAS bf16x8*)(lds + PG8_SA(b, h) + aoff + m * 2048 + k * 1024); } while (0)
#define PG8_LDB(dst, b, h) do { _Pragma("unroll") for (int n = 0; n < 2; ++n) _Pragma("unroll") for (int k = 0; k < 2; ++k) dst[n][k] = *(const LAS bf16x8*)(lds + PG8_SB(b, h) + boff + n * 2048 + k * 1024); } while (0)
#define PG8_MMA(ai, bj, At, Bt) do { __builtin_amdgcn_s_setprio(3); _Pragma("unroll") for (int m = 0; m < 4; ++m) _Pragma("unroll") for (int n = 0; n < 2; ++n) _Pragma("unroll") for (int k = 0; k < 2; ++k) \
        acc[ai][bj][m][n] = __builtin_amdgcn_mfma_f32_16x16x32_bf16(Bt[n][k], At[m][k], acc[ai][bj][m][n], 0, 0, 0); __builtin_amdgcn_s_setprio(0); } while (0)
#define PG8_MMAZ(ai, bj, At, Bt) do { __builtin_amdgcn_s_setprio(3); _Pragma("unroll") for (int m = 0; m < 4; ++m) _Pragma("unroll") for (int n = 0; n < 2; ++n) { \
        acc[ai][bj][m][n] = __builtin_amdgcn_mfma_f32_16x16x32_bf16(Bt[n][0], At[m][0], (f32x4){0.f, 0.f, 0.f, 0.f}, 0, 0, 0); \
        acc[ai][bj][m][n] = __builtin_amdgcn_mfma_f32_16x16x32_bf16(Bt[n][1], At[m][1], acc[ai][bj][m][n], 0, 0, 0); } __builtin_amdgcn_s_setprio(0); } while (0)
#define PG8_WAIT_V(n) asm volatile("s_waitcnt vmcnt(" #n ")" ::: "memory")
#define PG8_WAIT_L(n) asm volatile("s_waitcnt lgkmcnt(" #n ")" ::: "memory")
#define PG8_BAR __builtin_amdgcn_s_barrier()
#define PG8_SCHED __builtin_amdgcn_sched_barrier(0)
    Unit cur, nxt; int ui = 0;
    const bool incr = ((S.nwg | S.G) & 7) == 0 && (S.nM % WGM) == 0;
    StaticOrder::Pos pos;
    if (incr) { if (!S.first(pos, cur)) return; } else if (!S.next(0, cur)) return;
    constexpr int RS_LDS = LDSCTL_OFF + 8192;
#define PG8_RS_DMA(pm_, par_) do { if constexpr (Epi::RSTD) { unsigned vo__ = (unsigned)tid * 16u; asm volatile("" : "+v"(vo__)); \
        __builtin_amdgcn_global_load_lds((const unsigned*)((const char*)E.rs_src() + (size_t)(pm_) * 8192 + vo__), (LAS unsigned*)(lds + RS_LDS + (par_) * 8192 + ldsw), 16, 0, 0); } } while (0)
    PG8_RS_DMA(cur.pm, 0);
    f32x4 acc[2][2][4][2];
    bf16x8 At[4][2], B0[2][2], B1[2][2];
    const char* cA = (const char*)g.A + (size_t)cur.pm * tstepA; const char* cB = (const char*)g.Bt + (size_t)cur.pn * tstepB;
    PG8_STAGE(PG8_SB(0, 0), cB, voffB); PG8_STAGE(PG8_SB(0, 1), cB + hstepB, voffB); PG8_STAGE(PG8_SA(0, 0), cA, voffA); PG8_STAGE(PG8_SA(0, 1), cA + hstepA, voffA);
    if (wr == 1) PG8_BAR;
    PG8_WAIT_V(2); PG8_BAR;
    PG8_STAGE(PG8_SB(1, 0), cB + kstep, voffB); PG8_STAGE(PG8_SA(1, 0), cA + kstep, voffA); PG8_STAGE(PG8_SB(1, 1), cB + hstepB + kstep, voffB);
    PG8_WAIT_V(6); PG8_BAR;
    for (;;) {
        const bool has_next = incr ? S.step(pos, nxt) : S.next(ui + 1, nxt);
        const char* nA = has_next ? (const char*)g.A + (size_t)nxt.pm * tstepA : cA; const char* nB = has_next ? (const char*)g.Bt + (size_t)nxt.pn * tstepB : cB;
#define PG8_ITER(MMA0_) do { \
            const bool last = (t == nt - 2); \
            const char* a1 = cA + (size_t)(t + 1) * kstep; \
            const char* a2 = last ? nA : cA + (size_t)(t + 2) * kstep; const char* b2 = last ? nB : cB + (size_t)(t + 2) * kstep; \
            const char* a3 = a2 + kstep; const char* b3 = b2 + kstep; \
            PG8_LDB(B0, 0, 0); PG8_LDB(B1, 0, 1); PG8_SCHED; PG8_LDA(At, 0, 0); PG8_STAGE(PG8_SA(1, 1), a1 + hstepA, voffA); \
            PG8_WAIT_V(8); PG8_WAIT_L(0); PG8_BAR; MMA0_(0, 0, At, B0); MMA0_(0, 1, At, B1); PG8_BAR; PG8_SCHED; \
            PG8_LDA(At, 0, 1); PG8_STAGE(PG8_SB(0, 0), b2, voffB); PG8_STAGE(PG8_SB(0, 1), b2 + hstepB, voffB); PG8_STAGE(PG8_SA(0, 0), a2, voffA); \
            PG8_WAIT_V(8); PG8_WAIT_L(0); PG8_BAR; MMA0_(1, 0, At, B0); MMA0_(1, 1, At, B1); PG8_BAR; PG8_SCHED; \
            PG8_LDB(B0, 1, 0); PG8_LDB(B1, 1, 1); PG8_SCHED; PG8_LDA(At, 1, 0); PG8_STAGE(PG8_SA(0, 1), a2 + hstepA, voffA); \
            PG8_WAIT_V(8); PG8_WAIT_L(0); PG8_BAR; PG8_MMA(0, 0, At, B0); PG8_MMA(0, 1, At, B1); PG8_BAR; PG8_SCHED; \
            PG8_LDA(At, 1, 1); PG8_STAGE(PG8_SB(1, 0), b3, voffB); PG8_STAGE(PG8_SB(1, 1), b3 + hstepB, voffB); PG8_STAGE(PG8_SA(1, 0), a3, voffA); \
            PG8_WAIT_V(8); PG8_WAIT_L(0); PG8_BAR; PG8_MMA(1, 0, At, B0); PG8_MMA(1, 1, At, B1); PG8_BAR; PG8_SCHED; } while (0)
        { const int t = 0; PG8_ITER(PG8_MMAZ); }
        for (int t = 2; t < nt; t += 2) PG8_ITER(PG8_MMA);
#undef PG8_ITER
        if (Epi::ALIGN && wr == 0) PG8_BAR;
        { int tz = MY_TID(wave); asm volatile("" : "+v"(tz));
          const int wid2 = tz >> 6, lane2 = tz & 63;
          if constexpr (Epi::RSTD) {
              float rs[8];
              { const int ra = (int)(uintptr_t)lds + RS_LDS + (ui & 1) * 8192 + ((wid2 >> 2) * 64 + (lane2 & 15)) * 32;
                f32x4 sa[8], sb[8];
#define PG8_RS_RD(k, OFF) sa[k] = lds_rd128f<(OFF) * 32>(ra); sb[k] = lds_rd128f<(OFF) * 32 + 16>(ra)
                PG8_RS_RD(0, 0); PG8_RS_RD(1, 16); PG8_RS_RD(2, 32); PG8_RS_RD(3, 48); PG8_RS_RD(4, 128); PG8_RS_RD(5, 144); PG8_RS_RD(6, 160); PG8_RS_RD(7, 176);
#undef PG8_RS_RD
                asm volatile("s_waitcnt lgkmcnt(0)" : "+v"(sa[0]), "+v"(sa[1]), "+v"(sa[2]), "+v"(sa[3]), "+v"(sa[4]), "+v"(sa[5]), "+v"(sa[6]), "+v"(sa[7]),
                                                        "+v"(sb[0]), "+v"(sb[1]), "+v"(sb[2]), "+v"(sb[3]), "+v"(sb[4]), "+v"(sb[5]), "+v"(sb[6]), "+v"(sb[7]) :: "memory");
#pragma unroll
                for (int k = 0; k < 8; ++k) { const float s = ((sa[k].x + sa[k].y) + (sa[k].z + sa[k].w)) + ((sb[k].x + sb[k].y) + (sb[k].z + sb[k].w)); rs[k] = __builtin_amdgcn_rsqf(s * Epi::INV_N + RMS_EPS); } }
              E.run_rs(acc, cur, wid2 >> 2, wid2 & 3, lane2 & 15, lane2 >> 4, rs);
              if (has_next) PG8_RS_DMA(nxt.pm, (ui + 1) & 1);
          }
          else E(acc, cur, wid2 >> 2, wid2 & 3, lane2 & 15, lane2 >> 4);
          if (Epi::PROBE2 && PROBE_EPI > 1) { asm volatile("" : "+v"(tz)); const int wid3 = tz >> 6, lane3 = tz & 63; E.second(acc, cur, wid3 >> 2, wid3 & 3, lane3 & 15, lane3 >> 4); } }
        if (!has_next) break;
        cur = nxt; cA = nA; cB = nB; ++ui;
        if (Epi::ALIGN && wr == 1) PG8_BAR;
    }
    if (!Epi::ALIGN && wr == 0) PG8_BAR;
    PG8_WAIT_V(0);
    PG8_BAR;
#undef PG8_RS_DMA
#undef PG8_SA
#undef PG8_SB
#undef PG8_STAGE
#undef PG8_LDA
#undef PG8_LDB
#undef PG8_MMA
#undef PG8_MMAZ
#undef PG8_WAIT_V
#undef PG8_WAIT_L
#undef PG8_BAR
#undef PG8_SCHED
}
}

__device__ __forceinline__ float rsq(float x) { return __builtin_amdgcn_rsqf(x); }
constexpr float QS128 = 0.08838834764831845f * 1.4426950408889634f;
constexpr float QS192 = 0.07216878364870322f * 1.4426950408889634f;
__device__ __forceinline__ void rstd8_8(const float* ss, int row0, float inv_n, float (&rs)[8]) {
#pragma unroll
    for (int h = 0; h < 2; ++h) {
        f32x4 a[4], b[4];
#pragma unroll
        for (int i = 0; i < 4; ++i) { const f32x4* p = (const f32x4*)(ss + (size_t)(row0 + h * 128 + i * 16) * 8); a[i] = p[0]; b[i] = p[1]; }
#pragma unroll
        for (int i = 0; i < 4; ++i) { const float s = ((a[i].x + a[i].y) + (a[i].z + a[i].w)) + ((b[i].x + b[i].y) + (b[i].z + b[i].w)); rs[h * 4 + i] = rsq(s * inv_n + RMS_EPS); }
        asm volatile("" : "+v"(rs[h * 4 + 0]), "+v"(rs[h * 4 + 1]), "+v"(rs[h * 4 + 2]), "+v"(rs[h * 4 + 3]));
    }
}
__device__ __forceinline__ void rs_issue(const float* ss, int row0, int h, f32x4 (&a)[4], f32x4 (&b)[4]) {
#pragma unroll
    for (int i = 0; i < 4; ++i) { const f32x4* p = (const f32x4*)(ss + (size_t)(row0 + h * 128 + i * 16) * 8); a[i] = p[0]; b[i] = p[1]; }
}
__device__ __forceinline__ void rs_finish(const f32x4 (&a)[4], const f32x4 (&b)[4], float inv_n, float* rs) {
#pragma unroll
    for (int i = 0; i < 4; ++i) { const float s = ((a[i].x + a[i].y) + (a[i].z + a[i].w)) + ((b[i].x + b[i].y) + (b[i].z + b[i].w)); rs[i] = rsq(s * inv_n + RMS_EPS); }
}
__device__ __forceinline__ u32x4 pack8(const f32x4 v0, const f32x4 v1) {
    u32x4 w; w.x = cvt_pk_bf16(v0[0], v0[1]); w.y = cvt_pk_bf16(v0[2], v0[3]); w.z = cvt_pk_bf16(v1[0], v1[1]); w.w = cvt_pk_bf16(v1[2], v1[3]); return w;
}
__device__ __forceinline__ float sq4(const f32x4 v) { return (v[0] * v[0] + v[1] * v[1]) + (v[2] * v[2] + v[3] * v[3]); }

template <int SRC> struct EpiScaleBf16 {
    static constexpr bool PROBE2 = (PROBE_EPI_WHICH == 1) && (SRC == 1), PREFETCH = false, RSTD = (SRC != 0), ALIGN = false;
    static constexpr float INV_N = (SRC == 1) ? 1.0f / 2048.0f : 1.0f / 512.0f;
    bf16_t* O; int ldc; const float* ss;
    __device__ __forceinline__ const float* rs_src() const { return ss; }
    __device__ __forceinline__ void run_rs(const f32x4 (&acc)[2][2][4][2], const pg8::Unit& u, int wr, int wc, int fr, int fq, const float (&rs)[8]) const { store(acc, u, wr, wc, fr, fq, rs, 0); store(acc, u, wr, wc, fr, fq, rs, 1); }
    __device__ __forceinline__ void rs_first(const pg8::Unit& u, int wr, int fr, float (&rs)[8]) const { rstd8_8(ss, u.pm * 256 + wr * 64 + fr, INV_N, rs); }
    __device__ __forceinline__ void second(const f32x4 (&acc)[2][2][4][2], const pg8::Unit& u, int wr, int wc, int fr, int fq) const { float rs[8]; rs_first(u, wr, fr, rs); store(acc, u, wr, wc, fr, fq, rs, 0); store(acc, u, wr, wc, fr, fq, rs, 1); }
    __device__ __forceinline__ void store(const f32x4 (&acc)[2][2][4][2], const pg8::Unit& u, int wr, int wc, int fr, int fq, const float (&rs)[8], const int ai) const {
        const int row0 = u.pm * 256 + wr * 64 + fr, col0 = u.pn * 256 + wc * 32 + 8 * fq;
        const float qs = (SRC == 1 && (u.pn < 6 || u.pn >= 18)) ? QS128 : 1.0f;
#pragma unroll
        for (int m = 0; m < 4; ++m) { bf16_t* rowp = O + (size_t)(row0 + ai * 128 + m * 16) * ldc + col0; const float s = SRC ? rs[ai * 4 + m] * qs : 1.0f;
#pragma unroll
            for (int bj = 0; bj < 2; ++bj) *(u32x4*)(rowp + bj * 128) = pack8(acc[ai][bj][m][0] * s, acc[ai][bj][m][1] * s); }
    }
    __device__ __forceinline__ void operator()(const f32x4 (&acc)[2][2][4][2], const pg8::Unit& u, int wr, int wc, int fr, int fq) const {
        float rs[8]; if (SRC) rs_first(u, wr, fr, rs); store(acc, u, wr, wc, fr, fq, rs, 0); store(acc, u, wr, wc, fr, fq, rs, 1);
    }
    __device__ __forceinline__ void run(const f32x4 (&acc)[2][2][4][2], const pg8::Unit& u, int wr, int wc, int fr, int fq, const float (&rs)[8], bool has_next, const pg8::Unit& nx, float (&rsn)[8]) const {
        const int nrow0 = nx.pm * 256 + wr * 64 + fr;
        f32x4 na[4], nb[4];
        if (has_next) rs_issue(ss, nrow0, 0, na, nb);
        store(acc, u, wr, wc, fr, fq, rs, 0);
        if (has_next) { rs_finish(na, nb, INV_N, &rsn[0]); asm volatile("" : "+v"(rsn[0]), "+v"(rsn[1]), "+v"(rsn[2]), "+v"(rsn[3])); rs_issue(ss, nrow0, 1, na, nb); }
        store(acc, u, wr, wc, fr, fq, rs, 1);
        if (has_next) { rs_finish(na, nb, INV_N, &rsn[4]); asm volatile("" : "+v"(rsn[4]), "+v"(rsn[5]), "+v"(rsn[6]), "+v"(rsn[7])); }
    }
};
__device__ __forceinline__ f32x4 bf2f_lo(const u32x4 w) { return (f32x4){__uint_as_float(w.x << 16), __uint_as_float(w.x & 0xffff0000u), __uint_as_float(w.y << 16), __uint_as_float(w.y & 0xffff0000u)}; }
__device__ __forceinline__ f32x4 bf2f_hi(const u32x4 w) { return (f32x4){__uint_as_float(w.z << 16), __uint_as_float(w.z & 0xffff0000u), __uint_as_float(w.w << 16), __uint_as_float(w.w & 0xffff0000u)}; }
template <bool INF32, bool OUTF32> struct EpiResid {
    static constexpr bool PROBE2 = (PROBE_EPI_WHICH == 2) && !INF32 && !OUTF32, PREFETCH = false, RSTD = false, ALIGN = true;
    const float* hin; float* hout; bf16_t* hb; float* ss; LAS float* red;
    __device__ __forceinline__ void operator()(const f32x4 (&acc)[2][2][4][2], const pg8::Unit& u, int wr, int wc, int fr, int fq) const { run(acc, u, wr, wc, fr, fq, 1.0f); }
    __device__ __forceinline__ void second(const f32x4 (&acc)[2][2][4][2], const pg8::Unit& u, int wr, int wc, int fr, int fq) const { run(acc, u, wr, wc, fr, fq, 0.0f); }
    __device__ __forceinline__ void run(const f32x4 (&acc)[2][2][4][2], const pg8::Unit& u, int wr, int wc, int fr, int fq, const float sc) const {
        const int row0 = u.pm * 256 + wr * 64 + fr, col0 = u.pn * 256 + wc * 32 + 8 * fq;
        constexpr int NB = INF32 ? 2 : 1, AB = 2 / NB;
#pragma unroll
        for (int b = 0; b < NB; ++b) {
            u32x4 hw[AB][4][2]; f32x4 ha[AB][4][2], hc[AB][4][2];
#pragma unroll
            for (int a2 = 0; a2 < AB; ++a2)
#pragma unroll
                for (int m = 0; m < 4; ++m)
#pragma unroll
                    for (int bj = 0; bj < 2; ++bj) { const int ai = b * AB + a2; const size_t off = (size_t)(row0 + ai * 128 + m * 16) * DM + col0 + bj * 128;
                        if (INF32) { ha[a2][m][bj] = *(const f32x4*)(hin + off); hc[a2][m][bj] = *(const f32x4*)(hin + off + 4); }
                        else hw[a2][m][bj] = *(const u32x4*)(hb + off); }
#pragma unroll
            for (int a2 = 0; a2 < AB; ++a2) { const int ai = b * AB + a2;
#pragma unroll
                for (int m = 0; m < 4; ++m) { const int row = row0 + ai * 128 + m * 16; const size_t off = (size_t)row * DM + col0; float q = 0.f;
#pragma unroll
                    for (int bj = 0; bj < 2; ++bj) {
                        const f32x4 r0 = INF32 ? ha[a2][m][bj] : bf2f_lo(hw[a2][m][bj]), r1 = INF32 ? hc[a2][m][bj] : bf2f_hi(hw[a2][m][bj]);
                        const f32x4 v0 = PROBE2 ? r0 + acc[ai][bj][m][0] * sc : r0 + acc[ai][bj][m][0], v1 = PROBE2 ? r1 + acc[ai][bj][m][1] * sc : r1 + acc[ai][bj][m][1];
                        if (OUTF32) { *(f32x4*)(hout + off + bj * 128) = v0; *(f32x4*)(hout + off + bj * 128 + 4) = v1; }
                        else *(u32x4*)(hb + off + bj * 128) = pack8(v0, v1);
                        q += sq4(v0) + sq4(v1); }
                    q += __shfl_xor(q, 16); q += __shfl_xor(q, 32);
                    if (fq == 0) red[(ai * 128 + wr * 64 + m * 16 + fr) * 4 + wc] = q; }
            }
        }
        asm volatile("s_waitcnt lgkmcnt(0)" ::: "memory"); __builtin_amdgcn_s_barrier(); asm volatile("" ::: "memory");
        int tz = ((wr * 4 + wc) << 6) | (fq * 16 + fr); asm volatile("" : "+v"(tz));
        if (tz < 256) { const f32x4 r = *(const LAS f32x4*)(red + tz * 4); ss[(size_t)(u.pm * 256 + tz) * 8 + u.pn] = (r.x + r.y) + (r.z + r.w); }
    }
};
struct EpiSwiglu {
    static constexpr bool PROBE2 = (PROBE_EPI_WHICH == 0), PREFETCH = false, RSTD = true, ALIGN = false;
    static constexpr float INV_N = 1.0f / 2048.0f;
    bf16_t* H; const float* ss; int coloff;
    __device__ __forceinline__ const float* rs_src() const { return ss; }
    __device__ __forceinline__ void run_rs(const f32x4 (&acc)[2][2][4][2], const pg8::Unit& u, int wr, int wc, int fr, int fq, const float (&rs)[8]) const { half(acc, u, wr, wc, fr, fq, rs, 0); half(acc, u, wr, wc, fr, fq, rs, 1); }
    __device__ __forceinline__ void rs_first(const pg8::Unit& u, int wr, int fr, float (&rs)[8]) const { rstd8_8(ss, u.pm * 256 + wr * 64 + fr, 1.0f / 2048.0f, rs); }
    __device__ __forceinline__ void second(const f32x4 (&acc)[2][2][4][2], const pg8::Unit& u, int wr, int wc, int fr, int fq) const { float rs[8]; rs_first(u, wr, fr, rs); half(acc, u, wr, wc, fr, fq, rs, 0); half(acc, u, wr, wc, fr, fq, rs, 1); }
    __device__ __forceinline__ void operator()(const f32x4 (&acc)[2][2][4][2], const pg8::Unit& u, int wr, int wc, int fr, int fq) const { second(acc, u, wr, wc, fr, fq); }
    __device__ __forceinline__ void half(const f32x4 (&acc)[2][2][4][2], const pg8::Unit& u, int wr, int wc, int fr, int fq, const float (&rs)[8], const int ai) const {
        const int row0 = u.pm * 256 + wr * 64 + fr, col0 = coloff + u.pn * 128 + wc * 32 + 8 * fq;
#pragma unroll
        for (int m = 0; m < 4; ++m) { const float s = rs[ai * 4 + m], sn = s * -1.4426950408889634f, s2 = s * s; f32x4 o[2];
#pragma unroll
            for (int n = 0; n < 2; ++n) { const f32x4 g = acc[ai][0][m][n]; const f32x4 t = g * sn; const f32x4 gu = g * acc[ai][1][m][n]; f32x4 r;
#pragma unroll
                for (int j = 0; j < 4; ++j) r[j] = __builtin_amdgcn_rcpf(1.0f + __builtin_amdgcn_exp2f(t[j]));
                o[n] = gu * (r * s2); }
            __builtin_nontemporal_store(pack8(o[0], o[1]), (u32x4*)(H + (size_t)(row0 + ai * 128 + m * 16) * FFN + col0)); }
    }
    __device__ __forceinline__ void run(const f32x4 (&acc)[2][2][4][2], const pg8::Unit& u, int wr, int wc, int fr, int fq, const float (&rs)[8], bool has_next, const pg8::Unit& nx, float (&rsn)[8]) const {
        const int nrow0 = nx.pm * 256 + wr * 64 + fr;
        f32x4 na[4], nb[4];
        if (has_next) rs_issue(ss, nrow0, 0, na, nb);
        half(acc, u, wr, wc, fr, fq, rs, 0);
        if (has_next) { rs_finish(na, nb, 1.0f / 2048.0f, &rsn[0]); asm volatile("" : "+v"(rsn[0]), "+v"(rsn[1]), "+v"(rsn[2]), "+v"(rsn[3])); rs_issue(ss, nrow0, 1, na, nb); }
        half(acc, u, wr, wc, fr, fq, rs, 1);
        if (has_next) { rs_finish(na, nb, 1.0f / 2048.0f, &rsn[4]); asm volatile("" : "+v"(rsn[4]), "+v"(rsn[5]), "+v"(rsn[6]), "+v"(rsn[7])); }
    }
};
struct EpiNull {
    static constexpr bool PROBE2 = false, PREFETCH = false, RSTD = false, ALIGN = true;
    __device__ __forceinline__ void second(const f32x4 (&acc)[2][2][4][2], const pg8::Unit& u, int wr, int wc, int fr, int fq) const {}
    float* sink;
    __device__ __forceinline__ void operator()(const f32x4 (&acc)[2][2][4][2], const pg8::Unit& u, int wr, int wc, int fr, int fq) const {
        f32x4 s = (f32x4){0.f, 0.f, 0.f, 0.f};
#pragma unroll
        for (int ai = 0; ai < 2; ++ai)
#pragma unroll
            for (int bj = 0; bj < 2; ++bj)
#pragma unroll
                for (int m = 0; m < 4; ++m) { s += acc[ai][bj][m][0]; s += acc[ai][bj][m][1]; }
        const float t = (s.x + s.y) + (s.z + s.w);
        if (t != t) sink[0] = t;
    }
};
__device__ __forceinline__ void rope4(f32x4& x1, f32x4& x2, const float* cosT, const float* sinT, int row, int i0) {
    const f32x4 c = *(const f32x4*)(cosT + (size_t)row * 32 + i0), s = *(const f32x4*)(sinT + (size_t)row * 32 + i0);
    const f32x4 o1 = x1 * c - x2 * s, o2 = x2 * c + x1 * s; x1 = o1; x2 = o2;
}
struct EpiBIn {
    static constexpr bool PROBE2 = false, PREFETCH = false, RSTD = true, ALIGN = false;
    static constexpr float INV_N = 1.0f / 2048.0f;
    __device__ __forceinline__ void second(const f32x4 (&acc)[2][2][4][2], const pg8::Unit& u, int wr, int wc, int fr, int fq) const {}
    bf16_t* pb; bf16_t* kr; const float* ss; float* ssq; float* ssl; const float* cosT; const float* sinT;
    __device__ __forceinline__ const float* rs_src() const { return ss; }
    __device__ __forceinline__ void run_rs(const f32x4 (&acc)[2][2][4][2], const pg8::Unit& u, int wr, int wc, int fr, int fq, const float (&rs)[8]) const {
        const int row0 = u.pm * 256 + wr * 64 + fr, col0 = u.pn * 256 + wc * 32 + 8 * fq, pn = u.pn;
        if (pn < 6) {
            const bool want = (pn < 2) || (pn >= 4); float* sqp = (pn < 2) ? ssq : ssl; const int slot = (pn & 1) * 4 + wc;
#pragma unroll
            for (int ai = 0; ai < 2; ++ai)
#pragma unroll
                for (int m = 0; m < 4; ++m) { const int row = row0 + ai * 128 + m * 16; const float s = rs[ai * 4 + m] * (want ? 1.0f : QS128); float q = 0.f;
#pragma unroll
                    for (int bj = 0; bj < 2; ++bj) { const f32x4 v0 = acc[ai][bj][m][0] * s, v1 = acc[ai][bj][m][1] * s;
                        *(u32x4*)(pb + (size_t)row * PB_LD + col0 + bj * 128) = pack8(v0, v1); q += sq4(v0) + sq4(v1); }
                    q += __shfl_xor(q, 16); q += __shfl_xor(q, 32);
                    if (want && fq == 0) sqp[(size_t)row * 8 + slot] = q; }
        } else if (wc < 2) {
            const int i0 = 4 * (4 * wc + fq);
#pragma unroll
            for (int ai = 0; ai < 2; ++ai)
#pragma unroll
                for (int m = 0; m < 4; ++m) { const int row = row0 + ai * 128 + m * 16; const float s = rs[ai * 4 + m];
                    f32x4 x1 = acc[ai][0][m][0] * s, x2 = acc[ai][0][m][1] * s; rope4(x1, x2, cosT, sinT, row, i0);
                    *(u32x4*)(kr + (size_t)row * 64 + wc * 32 + 8 * fq) = pack8(x1, x2); }
        }
    }
};
struct EpiUq {
    static constexpr bool PROBE2 = false, PREFETCH = false, RSTD = true, ALIGN = true;
    static constexpr float INV_N = 1.0f / 512.0f;
    __device__ __forceinline__ void second(const f32x4 (&acc)[2][2][4][2], const pg8::Unit& u, int wr, int wc, int fr, int fq) const {}
    bf16_t* q; const float* ssq; const float* cosT; const float* sinT;
    __device__ __forceinline__ const float* rs_src() const { return ssq; }
    __device__ __forceinline__ void run_rs(const f32x4 (&acc)[2][2][4][2], const pg8::Unit& u, int wr, int wc, int fr, int fq, const float (&rs)[8]) const {
        const int row0 = u.pm * 256 + wr * 64 + fr, col0 = u.pn * 256 + wc * 32 + 8 * fq;
        const int i0 = 4 * (4 * (wc & 1) + fq);
#pragma unroll
        for (int ai = 0; ai < 2; ++ai)
#pragma unroll
            for (int m = 0; m < 4; ++m) { const int row = row0 + ai * 128 + m * 16; const float s = rs[ai * 4 + m] * QS192;
#pragma unroll
                for (int bj = 0; bj < 2; ++bj) { f32x4 v0 = acc[ai][bj][m][0] * s, v1 = acc[ai][bj][m][1] * s;
                    const int gb = 4 * u.pn + 2 * bj + (wc >> 1);
                    if (gb % 3 == 2) rope4(v0, v1, cosT, sinT, row, i0);
                    *(u32x4*)(q + (size_t)row * UQ_N + col0 + bj * 128) = pack8(v0, v1); } }
    }
};

namespace att {
__device__ __forceinline__ int crow(int r, int hi) { return (r & 3) + 8 * (r >> 2) + 4 * hi; }
__device__ __forceinline__ int key2slot(int k) { const int hi = k >> 5, h = (k >> 4) & 1, r = k & 15; return 32 * h + (r & 3) + 8 * (r >> 2) + 4 * hi; }
__device__ __forceinline__ int slot2key(int s) { const int h = s >> 5, rho = s & 31, hi = (rho >> 2) & 1, r = (rho & 3) | ((rho >> 3) << 2); return 32 * hi + 16 * h + r; }
__device__ __forceinline__ int v_st(int k, int c) { const int kk = (k & ~0xC) | ((k & 4) << 1) | ((k & 8) >> 1); return ((kk >> 3) * 4 + (c >> 5)) * 512 + ((kk & 7) * 32 + (c & 31)) * 2; }
__device__ __forceinline__ int v_rd_base(int lane) { return ((lane & 3) << 3) | (((lane >> 2) & 3) << 6) | (((lane >> 4) & 1) << 5) | (((lane >> 5) & 1) << 8); }
constexpr int v_rd_off(int d0, int ks, int half) { return d0 * 512 + ks * 4096 + half * 2048; }
template <int OFF> __device__ __forceinline__ bf16x8 lds_rd128(int addr) { bf16x8 r; asm volatile("ds_read_b128 %0, %1 offset:%2" : "=&v"(r) : "v"(addr), "i"(OFF) : "memory"); return r; }
__device__ __forceinline__ float lds_rd32(int addr) { float r; asm volatile("ds_read_b32 %0, %1" : "=&v"(r) : "v"(addr) : "memory"); return r; }
__device__ __forceinline__ unsigned lds_rd32u(int addr) { unsigned r; asm volatile("ds_read_b32 %0, %1" : "=&v"(r) : "v"(addr) : "memory"); return r; }
__device__ __forceinline__ void lds_wr32(int addr, float v) { asm volatile("ds_write_b32 %0, %1" :: "v"(addr), "v"(v) : "memory"); }
__device__ __forceinline__ void lds_wr32u(int addr, unsigned v) { asm volatile("ds_write_b32 %0, %1" :: "v"(addr), "v"(v) : "memory"); }
#define ATT_LGKM0() asm volatile("s_waitcnt lgkmcnt(0)" ::: "memory")
template <int OFF> __device__ __forceinline__ s16x4 tr_read(int vb) {
    s16x4 r; asm volatile("ds_read_b64_tr_b16 %0, %1 offset:%2" : "=&v"(r) : "v"(vb), "i"(OFF) : "memory"); return r;
}
struct VFrag { s16x4 l0, h0, l1, h1, l2, h2, l3, h3; };
template <int D0> __device__ __forceinline__ void pv_issue(VFrag& f, int vb) {
    f.l0 = tr_read<v_rd_off(D0, 0, 0)>(vb); f.h0 = tr_read<v_rd_off(D0, 0, 1)>(vb); f.l1 = tr_read<v_rd_off(D0, 1, 0)>(vb); f.h1 = tr_read<v_rd_off(D0, 1, 1)>(vb);
    f.l2 = tr_read<v_rd_off(D0, 2, 0)>(vb); f.h2 = tr_read<v_rd_off(D0, 2, 1)>(vb); f.l3 = tr_read<v_rd_off(D0, 3, 0)>(vb); f.h3 = tr_read<v_rd_off(D0, 3, 1)>(vb);
}
template <int N> __device__ __forceinline__ void pv_wait(VFrag& f) {
    asm volatile("s_waitcnt lgkmcnt(%8)" : "+v"(f.l0), "+v"(f.h0), "+v"(f.l1), "+v"(f.h1), "+v"(f.l2), "+v"(f.h2), "+v"(f.l3), "+v"(f.h3) : "i"(N) : "memory");
    __builtin_amdgcn_sched_barrier(0);
}
__device__ __forceinline__ void pv_mma(f32x16& od, const VFrag& f, bf16x8 pb0, bf16x8 pb1, bf16x8 pb2, bf16x8 pb3) {
#define ATT_PK(L, H) (bf16x8){L[0], L[1], L[2], L[3], H[0], H[1], H[2], H[3]}
    od = __builtin_amdgcn_mfma_f32_32x32x16_bf16(ATT_PK(f.l0, f.h0), pb0, od, 0, 0, 0);
    od = __builtin_amdgcn_mfma_f32_32x32x16_bf16(ATT_PK(f.l1, f.h1), pb1, od, 0, 0, 0);
    od = __builtin_amdgcn_mfma_f32_32x32x16_bf16(ATT_PK(f.l2, f.h2), pb2, od, 0, 0, 0);
    od = __builtin_amdgcn_mfma_f32_32x32x16_bf16(ATT_PK(f.l3, f.h3), pb3, od, 0, 0, 0);
#undef ATT_PK
    __builtin_amdgcn_sched_barrier(0);
}
__device__ __forceinline__ void pv_tile(f32x16 (&o)[4], int vb, bf16x8 pa0, bf16x8 pa1, bf16x8 pa2, bf16x8 pa3) {
    VFrag x, y;
    pv_issue<0>(x, vb); pv_issue<1>(y, vb);
    pv_wait<8>(x); pv_mma(o[0], x, pa0, pa1, pa2, pa3); pv_issue<2>(x, vb);
    pv_wait<8>(y); pv_mma(o[1], y, pa0, pa1, pa2, pa3); pv_issue<3>(y, vb);
    pv_wait<8>(x); pv_mma(o[2], x, pa0, pa1, pa2, pa3);
    pv_wait<0>(y); pv_mma(o[3], y, pa0, pa1, pa2, pa3);
}
__device__ __forceinline__ float sum16(const f32x16& p) {
    float a, b;
    asm volatile("s_nop 0\n\t"
                 "v_add_f32 %0, %2, %3\n\tv_add_f32 %1, %4, %5\n\t"
                 "v_add_f32 %0, %0, %6\n\tv_add_f32 %1, %1, %7\n\t"
                 "v_add_f32 %0, %0, %8\n\tv_add_f32 %1, %1, %9\n\t"
                 "v_add_f32 %0, %0, %10\n\tv_add_f32 %1, %1, %11\n\t"
                 "v_add_f32 %0, %0, %12\n\tv_add_f32 %1, %1, %13\n\t"
                 "v_add_f32 %0, %0, %14\n\tv_add_f32 %1, %1, %15\n\t"
                 "v_add_f32 %0, %0, %16\n\tv_add_f32 %1, %1, %17"
                 : "=&v"(a), "=&v"(b)
                 : "v"(p[0]), "v"(p[1]), "v"(p[2]), "v"(p[3]), "v"(p[4]), "v"(p[5]), "v"(p[6]), "v"(p[7]),
                   "v"(p[8]), "v"(p[9]), "v"(p[10]), "v"(p[11]), "v"(p[12]), "v"(p[13]), "v"(p[14]), "v"(p[15]));
    return a + b;
}
__device__ __forceinline__ void add1_16(f32x16& p) {
    float e0 = p[0], e1 = p[1], e2 = p[2], e3 = p[3], e4 = p[4], e5 = p[5], e6 = p[6], e7 = p[7], e8 = p[8], e9 = p[9], e10 = p[10], e11 = p[11], e12 = p[12], e13 = p[13], e14 = p[14], e15 = p[15];
    asm volatile("s_nop 0\n\t"
                 "v_add_f32 %0, 1.0, %0\n\tv_add_f32 %1, 1.0, %1\n\tv_add_f32 %2, 1.0, %2\n\tv_add_f32 %3, 1.0, %3\n\t"
                 "v_add_f32 %4, 1.0, %4\n\tv_add_f32 %5, 1.0, %5\n\tv_add_f32 %6, 1.0, %6\n\tv_add_f32 %7, 1.0, %7\n\t"
                 "v_add_f32 %8, 1.0, %8\n\tv_add_f32 %9, 1.0, %9\n\tv_add_f32 %10, 1.0, %10\n\tv_add_f32 %11, 1.0, %11\n\t"
                 "v_add_f32 %12, 1.0, %12\n\tv_add_f32 %13, 1.0, %13\n\tv_add_f32 %14, 1.0, %14\n\tv_add_f32 %15, 1.0, %15"
                 : "+v"(e0), "+v"(e1), "+v"(e2), "+v"(e3), "+v"(e4), "+v"(e5), "+v"(e6), "+v"(e7), "+v"(e8), "+v"(e9), "+v"(e10), "+v"(e11), "+v"(e12), "+v"(e13), "+v"(e14), "+v"(e15));
    p = (f32x16){e0, e1, e2, e3, e4, e5, e6, e7, e8, e9, e10, e11, e12, e13, e14, e15};
}
__device__ __forceinline__ void diff16(f32x16& p, float& prev) {
    float e0 = p[0], e1 = p[1], e2 = p[2], e3 = p[3], e4 = p[4], e5 = p[5], e6 = p[6], e7 = p[7], e8 = p[8], e9 = p[9], e10 = p[10], e11 = p[11], e12 = p[12], e13 = p[13], e14 = p[14], e15 = p[15];
    float nprev;
    asm volatile("s_nop 0\n\t"
                 "v_mov_b32 %16, %0\n\t"
                 "v_sub_f32 %0, %1, %0\n\tv_sub_f32 %1, %2, %1\n\tv_sub_f32 %2, %3, %2\n\tv_sub_f32 %3, %4, %3\n\t"
                 "v_sub_f32 %4, %5, %4\n\tv_sub_f32 %5, %6, %5\n\tv_sub_f32 %6, %7, %6\n\tv_sub_f32 %7, %8, %7\n\t"
                 "v_sub_f32 %8, %9, %8\n\tv_sub_f32 %9, %10, %9\n\tv_sub_f32 %10, %11, %10\n\tv_sub_f32 %11, %12, %11\n\t"
                 "v_sub_f32 %12, %13, %12\n\tv_sub_f32 %13, %14, %13\n\tv_sub_f32 %14, %15, %14\n\tv_sub_f32 %15, %17, %15"
                 : "+v"(e0), "+v"(e1), "+v"(e2), "+v"(e3), "+v"(e4), "+v"(e5), "+v"(e6), "+v"(e7), "+v"(e8), "+v"(e9), "+v"(e10), "+v"(e11), "+v"(e12), "+v"(e13), "+v"(e14), "+v"(e15), "=&v"(nprev)
                 : "v"(prev));
    p = (f32x16){e0, e1, e2, e3, e4, e5, e6, e7, e8, e9, e10, e11, e12, e13, e14, e15};
    prev = nprev;
}
__device__ __forceinline__ void cumprod_hi(f32x16& a, f32x16& b) {
    float a8 = a[8], a9 = a[9], a10 = a[10], a11 = a[11], a12 = a[12], a13 = a[13], a14 = a[14], a15 = a[15], b8 = b[8], b9 = b[9], b10 = b[10], b11 = b[11], b12 = b[12], b13 = b[13], b14 = b[14], b15 = b[15];
    asm volatile("v_mul_f32 %6, %7, %6\n\tv_mul_f32 %14, %15, %14\n\tv_mul_f32 %5, %6, %5\n\tv_mul_f32 %13, %14, %13\n\t"
                 "v_mul_f32 %4, %5, %4\n\tv_mul_f32 %12, %13, %12\n\tv_mul_f32 %3, %4, %3\n\tv_mul_f32 %11, %12, %11\n\t"
                 "v_mul_f32 %2, %3, %2\n\tv_mul_f32 %10, %11, %10\n\tv_mul_f32 %1, %2, %1\n\tv_mul_f32 %9, %10, %9\n\t"
                 "v_mul_f32 %0, %1, %0\n\tv_mul_f32 %8, %9, %8"
                 : "+v"(a8), "+v"(a9), "+v"(a10), "+v"(a11), "+v"(a12), "+v"(a13), "+v"(a14), "+v"(a15), "+v"(b8), "+v"(b9), "+v"(b10), "+v"(b11), "+v"(b12), "+v"(b13), "+v"(b14), "+v"(b15));
    a[8] = a8; a[9] = a9; a[10] = a10; a[11] = a11; a[12] = a12; a[13] = a13; a[14] = a14; b[8] = b8; b[9] = b9; b[10] = b10; b[11] = b11; b[12] = b12; b[13] = b13; b[14] = b14;
}
__device__ __forceinline__ void cumprod_lo(f32x16& a, f32x16& b) {
    float a0 = a[0], a1 = a[1], a2 = a[2], a3 = a[3], a4 = a[4], a5 = a[5], a6 = a[6], a7 = a[7], b0 = b[0], b1 = b[1], b2 = b[2], b3 = b[3], b4 = b[4], b5 = b[5], b6 = b[6], b7 = b[7];
    asm volatile("v_mul_f32 %7, %16, %7\n\tv_mul_f32 %15, %17, %15\n\tv_mul_f32 %6, %7, %6\n\tv_mul_f32 %14, %15, %14\n\t"
                 "v_mul_f32 %5, %6, %5\n\tv_mul_f32 %13, %14, %13\n\tv_mul_f32 %4, %5, %4\n\tv_mul_f32 %12, %13, %12\n\t"
                 "v_mul_f32 %3, %4, %3\n\tv_mul_f32 %11, %12, %11\n\tv_mul_f32 %2, %3, %2\n\tv_mul_f32 %10, %11, %10\n\t"
                 "v_mul_f32 %1, %2, %1\n\tv_mul_f32 %9, %10, %9\n\tv_mul_f32 %0, %1, %0\n\tv_mul_f32 %8, %9, %8"
                 : "+v"(a0), "+v"(a1), "+v"(a2), "+v"(a3), "+v"(a4), "+v"(a5), "+v"(a6), "+v"(a7), "+v"(b0), "+v"(b1), "+v"(b2), "+v"(b3), "+v"(b4), "+v"(b5), "+v"(b6), "+v"(b7)
                 : "v"(a[8]), "v"(b[8]));
    a[0] = a0; a[1] = a1; a[2] = a2; a[3] = a3; a[4] = a4; a[5] = a5; a[6] = a6; a[7] = a7; b[0] = b0; b[1] = b1; b[2] = b2; b[3] = b3; b[4] = b4; b[5] = b5; b[6] = b6; b[7] = b7;
}
struct Args { const bf16_t* Q; int ldq; const bf16_t* K; int ldk; const bf16_t* Kr; int ldkr; const bf16_t* V; int ldv; bf16_t* O; int ldo; int q0; int ntiles; int wave; };

constexpr int AK_BUF = 24576, AV_OFF = 2 * AK_BUF, AV_BUF = 16384, AST_OFF = AV_OFF + 2 * AV_BUF, AFLAG_OFF = AST_OFF + 2048;
#define ATT_BAR() do { asm volatile("s_waitcnt lgkmcnt(0)" ::: "memory"); __builtin_amdgcn_s_barrier(); asm volatile("" ::: "memory"); } while (0)
template <int MODE, int DQK>
__device__ __forceinline__ void attn_unit(LAS unsigned char* lds, const Args& a) {
    constexpr int ND = DQK / 16;
    constexpr float THRS = 8.0f * 1.4426950408889634f;
    int tid_ = MY_TID(a.wave); asm volatile("" : "+v"(tid_));
    const int tid = tid_, wid = tid >> 6, lane = tid & 63, r32 = lane & 31, hi = lane >> 5;
    const int grp = __builtin_amdgcn_readfirstlane(wid >> 2);
    const int ldsb = (int)(uintptr_t)lds;
    const int st_a = ldsb + AST_OFF + wid * 256;
    const int fl_a = ldsb + AFLAG_OFF;
    bf16x8 qr[ND];
    { const bf16_t* Qw = a.Q + (size_t)(wid * 32 + r32) * a.ldq + hi * 8;
#pragma unroll
      for (int d0 = 0; d0 < ND; ++d0) qr[d0] = *(const bf16x8*)(Qw + d0 * 16); }
    f32x16 o[4];
#pragma unroll
    for (int d = 0; d < 4; ++d)
#pragma unroll
        for (int r = 0; r < 16; ++r) o[d][r] = 0.f;
    float l_reg = 0.f, carryP = 1.f;
    f32x16 nb;
#pragma unroll
    for (int r = 0; r < 16; ++r) nb[r] = 0.f;
    unsigned voffK[2], voffV[2], voffR;
#pragma unroll
    for (int i = 0; i < 2; ++i) {
        const int A = wid * 2048 + i * 1024 + lane * 16;
        { const int slot = A >> 8, ck = ((A >> 4) & 15) ^ (slot & 15); voffK[i] = (unsigned)(slot2key(slot) * a.ldk + ck * 8) * 2u; }
        { const int sub = A >> 9, within = (A & 511) >> 1, kk = ((sub >> 2) << 3) | (within >> 5), c = ((sub & 3) << 5) | (within & 31);
          const int slot = kk;
          voffV[i] = (unsigned)(slot2key(slot) * a.ldv + c) * 2u; }
    }
    { const int A = wid * 1024 + lane * 16, slot = A >> 7, ck = ((A >> 4) & 7) ^ ((slot >> 1) & 7); voffR = (unsigned)(slot2key(slot) * a.ldkr + ck * 8) * 2u; }
    const int kx = r32 & 15, kxr = (r32 >> 1) & 7;
    int koff[ND];
#pragma unroll
    for (int d0 = 0; d0 < ND; ++d0) { koff[d0] = (d0 < 8) ? (r32 * 256 + (((2 * d0 + hi) ^ kx) << 4)) : (16384 + r32 * 128 + (((2 * (d0 - 8) + hi) ^ kxr) << 4)); asm volatile("" : "+v"(koff[d0])); }
    const int vb0 = (int)(uintptr_t)lds + AV_OFF + v_rd_base(lane);
    const int qpos = a.q0 + wid * 32 + r32, qmax = a.q0 + wid * 32 + 31;
    const int nt0 = a.ntiles; int nt = nt0;
#define ATT_TILE(t_) (((MODE == 0) ? (nt0 - 1 - (t_)) : (t_)) * 64)
#define ATT_DMA(gp_, voff_, ldsoff_) do { asm volatile("" : "+v"(voff_)); __builtin_amdgcn_global_load_lds((const unsigned*)(pg8::uptr((const char*)(gp_)) + (voff_)), (LAS unsigned*)(lds + (ldsoff_)), 16, 0, 0); } while (0)
#define ATT_DMAK(t_) do { const int k0_ = ATT_TILE(t_); const int kb_ = ((t_) & 1) * AK_BUF; const bf16_t* kp_ = a.K + (size_t)k0_ * a.ldk; \
        ATT_DMA(kp_, voffK[0], kb_ + a.wave * 2048); ATT_DMA(kp_, voffK[1], kb_ + a.wave * 2048 + 1024); \
        if (DQK == 192) { const bf16_t* rp_ = a.Kr + (size_t)k0_ * a.ldkr; ATT_DMA(rp_, voffR, kb_ + 16384 + a.wave * 1024); } } while (0)
#define ATT_DMAV(t_) do { const int k0_ = ATT_TILE(t_); const int vo_ = AV_OFF + ((t_) & 1) * AV_BUF; const bf16_t* vp_ = a.V + (size_t)k0_ * a.ldv; \
        ATT_DMA(vp_, voffV[0], vo_ + a.wave * 2048); ATT_DMA(vp_, voffV[1], vo_ + a.wave * 2048 + 1024); } while (0)
    if (MODE == 0 && lane < 2) lds_wr32u(fl_a + (lane * 8 + wid) * 4, 0u);
    ATT_BAR();
    ATT_DMAK(0);
    asm volatile("s_waitcnt vmcnt(0)" ::: "memory");
    ATT_BAR();
#pragma unroll
    for (int d0 = 0; d0 < ND; ++d0) asm volatile("" : "+v"(qr[d0]));
    bool actQ = false, actP = false;
    f32x16 p0, p1;
    if (grp == 1) { if (1 < nt0) ATT_DMAK(1); ATT_DMAV(0); ATT_BAR(); }
    for (int t = 0; t <= nt; ++t) {
        if (grp == 0) { if (t + 1 < nt0) ATT_DMAK(t + 1); if (t < nt0) ATT_DMAV(t); }
        else if (MODE == 0 && t >= 1) {
            unsigned fw[8];
#pragma unroll
            for (int w = 0; w < 8; ++w) fw[w] = lds_rd32u(fl_a + (((t - 1) & 1) * 8 + w) * 4);
            asm volatile("s_waitcnt lgkmcnt(0)" : "+v"(fw[0]), "+v"(fw[1]), "+v"(fw[2]), "+v"(fw[3]), "+v"(fw[4]), "+v"(fw[5]), "+v"(fw[6]), "+v"(fw[7]) :: "memory");
            unsigned alld = 1u;
#pragma unroll
            for (int w = 0; w < 8; ++w) alld &= fw[w];
            if (__builtin_amdgcn_readfirstlane(alld) && t < nt) nt = t;
        }
        if (t >= 1 && actP) {
            const int vb = vb0 + ((t - 1) & 1) * AV_BUF;
            u32x4 w0_ = {__float_as_uint(p0[0]), __float_as_uint(p0[1]), __float_as_uint(p0[2]), __float_as_uint(p0[3])}, w1_ = {__float_as_uint(p0[4]), __float_as_uint(p0[5]), __float_as_uint(p0[6]), __float_as_uint(p0[7])};
            u32x4 w2_ = {__float_as_uint(p0[8]), __float_as_uint(p0[9]), __float_as_uint(p0[10]), __float_as_uint(p0[11])}, w3_ = {__float_as_uint(p0[12]), __float_as_uint(p0[13]), __float_as_uint(p0[14]), __float_as_uint(p0[15])};
            const bf16x8 pa0 = __builtin_bit_cast(bf16x8, w0_), pa1 = __builtin_bit_cast(bf16x8, w1_), pa2 = __builtin_bit_cast(bf16x8, w2_), pa3 = __builtin_bit_cast(bf16x8, w3_);
            pv_tile(o, vb, pa0, pa1, pa2, pa3);
        }
        actQ = false;
        if (t < nt) {
            const int k0 = ATT_TILE(t);
            if (MODE == 0) actQ = (k0 < qmax) && !__all(carryP > 1e30f);
            else if (MODE == 1) actQ = (k0 <= qmax);
            else actQ = true;
            if (actQ) {
                const int K_a = ldsb + (t & 1) * AK_BUF;
#pragma unroll
                for (int r = 0; r < 16; ++r) { p0[r] = (MODE == 0) ? 0.f : nb[r]; p1[r] = (MODE == 0) ? 0.f : nb[r]; }
                constexpr int NC = ND / 2;
                bf16x8 xa[2], xb[2], ya[2], yb[2];
#define ATT_QK_ISSUE(c_, A_, B_) do { _Pragma("unroll") for (int i_ = 0; i_ < 2; ++i_) { const int d0 = 2 * (c_) + i_; \
        const int off = koff[d0]; \
        if (d0 < 8) { A_[i_] = lds_rd128<0>(K_a + off); B_[i_] = lds_rd128<32 * 256>(K_a + off); } else { A_[i_] = lds_rd128<0>(K_a + off); B_[i_] = lds_rd128<32 * 128>(K_a + off); } } } while (0)
#define ATT_QK_STEP(c_, A_, B_) do { if ((c_) + 1 < NC) asm volatile("s_waitcnt lgkmcnt(4)" : "+v"(A_[0]), "+v"(B_[0]), "+v"(A_[1]), "+v"(B_[1]) :: "memory"); \
        else asm volatile("s_waitcnt lgkmcnt(0)" : "+v"(A_[0]), "+v"(B_[0]), "+v"(A_[1]), "+v"(B_[1]) :: "memory"); \
        __builtin_amdgcn_sched_barrier(0); \
        p0 = __builtin_amdgcn_mfma_f32_32x32x16_bf16(A_[0], qr[2 * (c_)], p0, 0, 0, 0); p1 = __builtin_amdgcn_mfma_f32_32x32x16_bf16(B_[0], qr[2 * (c_)], p1, 0, 0, 0); \
        p0 = __builtin_amdgcn_mfma_f32_32x32x16_bf16(A_[1], qr[2 * (c_) + 1], p0, 0, 0, 0); p1 = __builtin_amdgcn_mfma_f32_32x32x16_bf16(B_[1], qr[2 * (c_) + 1], p1, 0, 0, 0); \
        __builtin_amdgcn_sched_barrier(0); \
        if ((c_) + 2 < NC) ATT_QK_ISSUE((c_) + 2, A_, B_); } while (0)
                ATT_QK_ISSUE(0, xa, xb); ATT_QK_ISSUE(1, ya, yb);
                ATT_QK_STEP(0, xa, xb); ATT_QK_STEP(1, ya, yb); ATT_QK_STEP(2, xa, xb); ATT_QK_STEP(3, ya, yb);
                if constexpr (NC > 4) { ATT_QK_STEP(4, xa, xb); ATT_QK_STEP(5, ya, yb); }
#undef ATT_QK_ISSUE
#undef ATT_QK_STEP
            }
        }
        if (grp == 1) asm volatile("s_waitcnt vmcnt(0)" ::: "memory");
        ATT_BAR();
        if (grp == 1) { if (t + 2 < nt0) ATT_DMAK(t + 2); if (t + 1 < nt0) ATT_DMAV(t + 1); }
        else if (MODE == 0 && t >= 1) {
            unsigned fw[8];
#pragma unroll
            for (int w = 0; w < 8; ++w) fw[w] = lds_rd32u(fl_a + (((t - 1) & 1) * 8 + w) * 4);
            asm volatile("s_waitcnt lgkmcnt(0)" : "+v"(fw[0]), "+v"(fw[1]), "+v"(fw[2]), "+v"(fw[3]), "+v"(fw[4]), "+v"(fw[5]), "+v"(fw[6]), "+v"(fw[7]) :: "memory");
            unsigned alld = 1u;
#pragma unroll
            for (int w = 0; w < 8; ++w) alld &= fw[w];
            if (__builtin_amdgcn_readfirstlane(alld) && t < nt) nt = t;
        }
        if (t < nt) {
        if (actQ) {
            const int k0 = ATT_TILE(t);
            const bool need_mask = (MODE != 2) && (k0 + 63 >= a.q0 + a.wave * 32);
            const int lim = qpos - (k0 + 32 * hi) + (MODE == 1 ? 1 : 0);
            if (MODE == 0) {
#pragma unroll
                for (int r = 0; r < 16; ++r) { p0[r] = __builtin_amdgcn_exp2f(p0[r]); p1[r] = __builtin_amdgcn_exp2f(p1[r]); }
                add1_16(p0); add1_16(p1);
                if (need_mask) {
#pragma unroll
                    for (int r = 0; r < 16; ++r) { p0[r] = (r < lim) ? p0[r] : 1.0f; p1[r] = (r + 16 < lim) ? p1[r] : 1.0f; }
                }
                cumprod_hi(p1, p0); cumprod_lo(p1, p0);
                const float run1 = p1[0], run0 = p0[0];
                const float run = run1 * run0;
                const auto rr = __builtin_amdgcn_permlane32_swap(__float_as_uint(run), __float_as_uint(run), false, false);
                const float tlo = __uint_as_float(rr[0]), thi = __uint_as_float(rr[1]);
                const float seed1 = carryP * (hi ? 1.0f : thi), seed0 = seed1 * run1;
                float sprev = __builtin_amdgcn_rcpf(seed1);
#pragma unroll
                for (int r = 0; r < 16; ++r) p1[r] = __builtin_amdgcn_rcpf(p1[r] * seed1);
                diff16(p1, sprev);
#pragma unroll
                for (int r = 0; r < 16; ++r) p0[r] = __builtin_amdgcn_rcpf(p0[r] * seed0);
                diff16(p0, sprev);
                carryP *= tlo * thi;
            } else {
                if (need_mask) {
#pragma unroll
                    for (int r = 0; r < 16; ++r) { p0[r] = (r < lim) ? p0[r] : -1e30f; p1[r] = (r + 16 < lim) ? p1[r] : -1e30f; }
                }
                float pmax = p0[0];
#pragma unroll
                for (int r = 1; r < 16; ++r) pmax = fmaxf(pmax, p0[r]);
#pragma unroll
                for (int r = 0; r < 16; ++r) pmax = fmaxf(pmax, p1[r]);
                { const auto rr = __builtin_amdgcn_permlane32_swap(__float_as_uint(pmax), __float_as_uint(pmax), false, false);
                  pmax = fmaxf(__uint_as_float(rr[0]), __uint_as_float(rr[1])); }
                if (t == 0) {
#pragma unroll
                    for (int r = 0; r < 16; ++r) { p0[r] -= pmax; p1[r] -= pmax; nb[r] = -pmax; }
                } else if (!__all(pmax <= THRS)) {
                    const float dm = fmaxf(pmax, 0.f);
                    const float alpha = __builtin_amdgcn_exp2f(-dm);
                    l_reg *= alpha;
#pragma unroll
                    for (int d = 0; d < 4; ++d)
#pragma unroll
                        for (int r = 0; r < 16; ++r) o[d][r] *= alpha;
#pragma unroll
                    for (int r = 0; r < 16; ++r) { p0[r] -= dm; p1[r] -= dm; nb[r] -= dm; }
                }
#pragma unroll
                for (int r = 0; r < 16; ++r) { p0[r] = __builtin_amdgcn_exp2f(p0[r]); p1[r] = __builtin_amdgcn_exp2f(p1[r]); }
                float ps = sum16(p0) + sum16(p1);
                { const auto rr = __builtin_amdgcn_permlane32_swap(__float_as_uint(ps), __float_as_uint(ps), false, false);
                  ps = __uint_as_float(rr[0]) + __uint_as_float(rr[1]); }
                l_reg += ps;
            }
            { unsigned w_[16];
#pragma unroll
              for (int i = 0; i < 8; ++i) { w_[i] = cvt_pk_bf16(p0[2 * i], p0[2 * i + 1]); w_[8 + i] = cvt_pk_bf16(p1[2 * i], p1[2 * i + 1]); }
#pragma unroll
              for (int i = 0; i < 16; ++i) p0[i] = __uint_as_float(w_[i]); }
        }
            actP = actQ;
            if (MODE == 0) { const bool dn = __all(carryP > 1e30f); if (lane == 0) lds_wr32u(fl_a + ((t & 1) * 8 + wid) * 4, dn ? 1u : 0u); }
        }
        if (grp == 0) asm volatile("s_waitcnt vmcnt(0)" ::: "memory");
        ATT_BAR();
    }
    if (grp == 0) ATT_BAR();
    asm volatile("s_waitcnt vmcnt(0)" ::: "memory");
#undef ATT_TILE
#undef ATT_DMA
#undef ATT_DMAK
#undef ATT_DMAV
    int tz = MY_TID(a.wave); asm volatile("" : "+v"(tz));
    const int wid2 = tz >> 6, r32b = tz & 31, hib = (tz >> 5) & 1;
    const float rl = (MODE != 0) ? __builtin_amdgcn_rcpf(l_reg) : 1.0f;
    bf16_t* Ow = a.O + (size_t)(wid2 * 32 + r32b) * a.ldo + 8 * hib;
#pragma unroll
    for (int d0 = 0; d0 < 4; ++d0)
#pragma unroll
        for (int k = 0; k < 2; ++k) {
            unsigned ax = cvt_pk_bf16(o[d0][8 * k + 0] * rl, o[d0][8 * k + 1] * rl), ay = cvt_pk_bf16(o[d0][8 * k + 2] * rl, o[d0][8 * k + 3] * rl);
            unsigned bx = cvt_pk_bf16(o[d0][8 * k + 4] * rl, o[d0][8 * k + 5] * rl), by = cvt_pk_bf16(o[d0][8 * k + 6] * rl, o[d0][8 * k + 7] * rl);
            const auto rx = __builtin_amdgcn_permlane32_swap(ax, bx, false, false); const auto ry = __builtin_amdgcn_permlane32_swap(ay, by, false, false);
            const u32x4 w = {rx[0], ry[0], rx[1], ry[1]};
            *(u32x4*)(Ow + d0 * 32 + 16 * k) = w;
        }
}
}

#define XB_TMO      128
#define XB_XCNT(j)  (256  + 64 * (j))
#define XB_XSUB(j)  (1280 + 64 * (j))
#define XB_XGEN(j)  (2304 + 64 * (j))
#define XB_TOP      3328
#define XB_TOPGEN   3392
#define XCD_BAR_WORDS 3456
#define XB_SPIN_CAP (1u << 22)
__device__ __forceinline__ unsigned xb_ld(unsigned* p)              { return __hip_atomic_load(p, __ATOMIC_RELAXED, __HIP_MEMORY_SCOPE_AGENT); }
__device__ __forceinline__ unsigned xb_add(unsigned* p, unsigned v) { return __hip_atomic_fetch_add(p, v, __ATOMIC_RELAXED, __HIP_MEMORY_SCOPE_AGENT); }
__device__ __forceinline__ unsigned xb_xcc_id() { return (unsigned)__builtin_amdgcn_s_getreg((3 << 11) | 20) & 0xFu; }
#define XB_SPIN(cond, bar) do { unsigned _sp = 0; while (cond) { __builtin_amdgcn_s_sleep(1); \
    if ((++_sp & 255u) == 0u) { if (xb_ld(&(bar)[XB_TMO])) break; if (_sp > XB_SPIN_CAP) { atomicAdd(&(bar)[XB_TMO], 1u); break; } } } } while (0)
struct XcdBarrier { unsigned* bar; unsigned x; volatile LAS unsigned* st; int wave; };
__device__ __forceinline__ XcdBarrier xcd_barrier_post(unsigned* bar, volatile LAS unsigned* st, int wave) {
    XcdBarrier b; b.bar = bar; b.x = xb_xcc_id(); b.st = st; b.wave = wave;
    if (MY_TID(wave) == 0) (void)xb_add(&bar[XB_XCNT(b.x)], 1u);
    return b;
}
__device__ __forceinline__ void xcd_barrier_complete(unsigned* bar, unsigned x, unsigned& nloc, unsigned& nx) {
    const unsigned G = gridDim.x * gridDim.y * gridDim.z;
    unsigned sum, cnt, mine, sp = 0u;
    for (;;) {
        sum = 0u; cnt = 0u; mine = 0u;
#pragma unroll
        for (unsigned j = 0; j < 16; ++j) { const unsigned c = xb_ld(&bar[XB_XCNT(j)]); sum += c; cnt += (c > 0u) ? 1u : 0u; mine = (j == x) ? c : mine; }
        if (sum == G) break;
        __builtin_amdgcn_s_sleep(1);
        if ((++sp & 255u) == 0u) { if (xb_ld(&bar[XB_TMO])) break; if (sp > XB_SPIN_CAP) { atomicAdd(&bar[XB_TMO], 1u); break; } }
    }
    nloc = mine > 0u ? mine : 1u; nx = cnt > 0u ? cnt : 1u;
}
__device__ __forceinline__ void xcd_barrier(const XcdBarrier& b) {
    asm volatile("s_waitcnt vmcnt(0)" ::: "memory");
    __syncthreads();
    if (MY_TID(b.wave) == 0) {
        unsigned* bar = b.bar;
        __builtin_amdgcn_s_waitcnt(0);
        unsigned nloc = b.st[0], nx = b.st[1];
        if (nloc == 0u) { xcd_barrier_complete(bar, b.x, nloc, nx); b.st[0] = nloc; b.st[1] = nx; }
        const unsigned old = xb_add(&bar[XB_XSUB(b.x)], 1u);
        const unsigned gen = old / nloc;
        if (old + 1u == (gen + 1u) * nloc) {
            __builtin_amdgcn_fence(__ATOMIC_RELEASE, "agent");
            asm volatile("s_waitcnt vmcnt(0)" ::: "memory");
            const unsigned og = xb_add(&bar[XB_TOP], 1u);
            const unsigned tg = og / nx;
            if (og + 1u == (tg + 1u) * nx) xb_add(&bar[XB_TOPGEN], 1u);
            else XB_SPIN(xb_ld(&bar[XB_TOPGEN]) == tg, bar);
            __builtin_amdgcn_fence(__ATOMIC_ACQUIRE, "agent");
            xb_add(&bar[XB_XGEN(b.x)], 1u);
            asm volatile("s_waitcnt vmcnt(0)" ::: "memory");
        } else {
            XB_SPIN(xb_ld(&bar[XB_XGEN(b.x)]) == gen, bar);
            __builtin_amdgcn_fence(__ATOMIC_ACQUIRE, "agent");
            asm volatile("s_waitcnt vmcnt(0)" ::: "memory");
        }
    }
    __syncthreads();
}

enum { MAP_ID = 0, MAP_GU = 1, MAP_DKV = 2, MAP_UQ = 3 };
struct CvtJob { int in_idx; int ldw; int K; int gain_idx; int gain_off; int dst_row0; int nrows; int map; long src_off; long dst_off; };
constexpr int NJOBS = 24;
__device__ const CvtJob JOBS[NJOBS] = {
    {5, 5120, 2048, 3, 0, 0, 5120, MAP_ID, 0L, (long)W_AIN},
    {5, 5120, 2048, 3, 2048, 0, 5120, MAP_ID, 2048L * 5120, (long)(W_AIN + (size_t)5120 * 2048 * 2)},
    {6, 2048, 2048, -1, 0, 0, 2048, MAP_ID, 0L, (long)W_AOUT},
    {6, 2048, 2048, -1, 0, 0, 2048, MAP_ID, 2048L * 2048, (long)(W_AOUT + (size_t)2048 * 2048 * 2)},
    {7, 1024, 2048, 3, 4096, 0, 1024, MAP_ID, 0L, (long)W_BIN},
    {7, 1024, 2048, 3, 6144, 0, 1024, MAP_ID, 2048L * 1024, (long)(W_BIN + (size_t)1792 * 2048 * 2)},
    {14, 576, 2048, 13, 0, 1024, 768, MAP_DKV, 0L, (long)W_BIN},
    {9, 2304, 512, 8, 0, 0, 2304, MAP_UQ, 0L, (long)W_UQ},
    {9, 2304, 512, 8, 512, 0, 2304, MAP_UQ, 512L * 2304, (long)(W_UQ + (size_t)2304 * 512 * 2)},
    {10, 2048, 2048, -1, 0, 0, 2048, MAP_ID, 0L, (long)W_BOUT},
    {10, 2048, 2048, -1, 0, 0, 2048, MAP_ID, 2048L * 2048, (long)(W_BOUT + (size_t)2048 * 2048 * 2)},
    {12, 1024, 2048, -1, 0, 0, 1024, MAP_ID, 0L, (long)W_MEMKV},
    {12, 1024, 2048, -1, 0, 1024, 1024, MAP_ID, 2048L * 1024, (long)W_MEMKV},
    {12, 1024, 2048, -1, 0, 2048, 1024, MAP_ID, 2L * 2048 * 1024, (long)W_MEMKV},
    {12, 1024, 2048, -1, 0, 3072, 1024, MAP_ID, 3L * 2048 * 1024, (long)W_MEMKV},
    {16, 3072, 512, 15, 0, 0, 3072, MAP_ID, 0L, (long)W_UKV},
    {17, 11264, 2048, 4, 0, 0, 11264, MAP_GU, 0L, (long)W_GU},
    {17, 11264, 2048, 4, 2048, 0, 11264, MAP_GU, 2048L * 11264, (long)(W_GU + (size_t)11264 * 2048 * 2)},
    {17, 11264, 2048, 4, 4096, 0, 11264, MAP_GU, 2L * 2048 * 11264, (long)(W_GU + (size_t)2 * 11264 * 2048 * 2)},
    {17, 11264, 2048, 4, 6144, 0, 11264, MAP_GU, 3L * 2048 * 11264, (long)(W_GU + (size_t)3 * 11264 * 2048 * 2)},
    {18, 2048, 5632, -1, 0, 0, 2048, MAP_ID, 0L, (long)W_DN},
    {18, 2048, 5632, -1, 0, 0, 2048, MAP_ID, 5632L * 2048, (long)(W_DN + (size_t)2048 * 5632 * 2)},
    {18, 2048, 5632, -1, 0, 0, 2048, MAP_ID, 2L * 5632 * 2048, (long)(W_DN + (size_t)2 * 2048 * 5632 * 2)},
    {18, 2048, 5632, -1, 0, 0, 2048, MAP_ID, 3L * 5632 * 2048, (long)(W_DN + (size_t)3 * 2048 * 5632 * 2)},
};
__device__ __forceinline__ int ropeperm(int p) { const int t = p >> 3, e = p & 7; return (e < 4) ? 4 * t + e : 32 + 4 * t + (e - 4); }
__device__ __forceinline__ int map_col(int map, int nr) {
    if (map == MAP_ID) return nr;
    if (map == MAP_GU) { const int tile = nr >> 8, j = nr & 255; return (j < 128) ? 128 * tile + j : FFN + 128 * tile + (j - 128); }
    if (map == MAP_DKV) { return (nr < 512) ? nr : ((nr < 576) ? 512 + ropeperm(nr - 512) : -1); }
    const int head = nr / 192, o = nr - head * 192; return (o < 128) ? nr : head * 192 + 128 + ropeperm(o - 128);
}

struct KArgs { const void* in[20]; float* out; unsigned char* ws; int ph_lo, ph_hi; };

__device__ __forceinline__ void cvt_load(const KArgs& A, const CvtJob& J, int item, int lane, f32x4 (&v)[8]) {
    const int nblk = J.nrows / 32, kb = item / nblk, nb = item - kb * nblk, k0 = 64 * kb, n0 = 32 * nb;
    const float* W = (const float*)A.in[J.in_idx] + J.src_off;
    const int col = map_col(J.map, n0 + 4 * (lane & 7));
    const float* wp = W + (size_t)(k0 + (lane >> 3)) * J.ldw + (col >= 0 ? col : 0);
#pragma unroll
    for (int i = 0; i < 8; ++i) v[i] = __builtin_nontemporal_load((const f32x4*)(wp + (size_t)(8 * i) * J.ldw));
}
__device__ __forceinline__ void cvt_store(const KArgs& A, const CvtJob& J, int item, LAS float* scr, int lane, const f32x4 (&v)[8]) {
    const int nblk = J.nrows / 32, kb = item / nblk, nb = item - kb * nblk, k0 = 64 * kb, n0 = 32 * nb;
    const int col = map_col(J.map, n0 + 4 * (lane & 7));
    const int c = lane & 7;
    f32x4 g0 = (f32x4){1.f, 1.f, 1.f, 1.f}, g1 = g0;
    if (J.gain_idx >= 0) { const float* gain = (const float*)A.in[J.gain_idx] + J.gain_off + k0 + 8 * c; g0 = *(const f32x4*)gain; g1 = *(const f32x4*)(gain + 4); }
#pragma unroll
    for (int i = 0; i < 8; ++i)
#pragma unroll
        for (int e = 0; e < 4; ++e) scr[(8 * i + (lane >> 3)) * 33 + 4 * c + e] = (col >= 0) ? v[i][e] : 0.f;
    asm volatile("s_waitcnt lgkmcnt(0)" ::: "memory");
    bf16_t* dst = (bf16_t*)(A.ws + J.dst_off);
#pragma unroll
    for (int j = 0; j < 4; ++j) { const int n = (lane >> 3) + 8 * j; const LAS float* s = scr + (8 * c) * 33 + n;
        u32x4 o; o.x = pk2(s[0 * 33] * g0[0], s[1 * 33] * g0[1]); o.y = pk2(s[2 * 33] * g0[2], s[3 * 33] * g0[3]); o.z = pk2(s[4 * 33] * g1[0], s[5 * 33] * g1[1]); o.w = pk2(s[6 * 33] * g1[2], s[7 * 33] * g1[3]);
        *(u32x4*)(dst + (size_t)(J.dst_row0 + n0 + n) * J.K + k0 + 8 * c) = o; }
    asm volatile("s_waitcnt lgkmcnt(0)" ::: "memory");
}
__device__ __forceinline__ bool cvt_locate(int g, int& jb, int& local) {
    int b = 0;
    for (jb = 0; jb < NJOBS; ++jb) { const int n = (JOBS[jb].nrows / 32) * (JOBS[jb].K / 64); if (g < b + n) { local = g - b; return true; } b += n; }
    return false;
}

struct Ctx { LAS unsigned char* lds; unsigned char* ws; float* out; const float* x; int G, bx, vcu, lo, hi, wave; XcdBarrier bar; };
#define IN(k) (lo <= (k) && (k) < hi)
#define SEAM(k) do { if ((k) + 1 < hi) xcd_barrier(bar); } while (0)
template <int L>
__device__ __forceinline__ void layer_phases(const Ctx& c) {
    LAS unsigned char* lds = c.lds; unsigned char* ws = c.ws; float* out = c.out; const float* x = c.x;
    const int G = c.G, bx = c.bx, vcu = c.vcu, lo = c.lo, hi = c.hi, wave = c.wave; const XcdBarrier bar = c.bar;
    float* SS = (float*)(ws + WS_SS); float* SSQ = (float*)(ws + WS_SSQ); float* SSL = (float*)(ws + WS_SSL);
    float* COS = (float*)(ws + WS_COS); float* SIN = (float*)(ws + WS_SIN);
    bf16_t* HB = (bf16_t*)(ws + WS_HB); bf16_t* KV = (bf16_t*)(ws + WS_KV); bf16_t* KR = (bf16_t*)(ws + WS_KR);
    bf16_t* MEMKV = (bf16_t*)(ws + WS_MEMKV); bf16_t* MEMN = (bf16_t*)(ws + WS_MEMN);
    bf16_t* PROJ = (bf16_t*)(ws + WS_PROJ); bf16_t* PB = (bf16_t*)(ws + WS_PB); bf16_t* QB = (bf16_t*)(ws + WS_Q);
    bf16_t* MIX = (bf16_t*)(ws + WS_MIX); bf16_t* HID = (bf16_t*)(ws + WS_HID);
    {
        constexpr int pb = 1 + 6 * L; constexpr bool isA = L < 2; constexpr int li = L & 1;
        if (IN(pb)) {
            if (L == 0) {
                pg8::Gemm g{MEMN, (const bf16_t*)(ws + W_MEMKV), MROWS, 4096, 2048, 2048, 2048}; pg8::StaticOrder S; S.init(MROWS, 4096, G, bx);
                EpiScaleBf16<0> E{MEMKV, 4096, nullptr};
                pg8::gemm_phase(lds, g, S, E, wave);
            }
            if (isA) {
                pg8::Gemm g{HB, (const bf16_t*)(ws + W_AIN) + (size_t)li * 5120 * 2048, M, A_IN, 2048, 2048, 2048}; pg8::StaticOrder S; S.init(M, A_IN, G, bx);
                EpiScaleBf16<1> E{PROJ, A_IN, SS};
                if (PROBE_NULL_AIN) { EpiNull E0{SSQ}; pg8::gemm_phase(lds, g, S, E0, wave); }
                pg8::gemm_phase(lds, g, S, E, wave);
            } else {
                const int N = (L == 2) ? 1792 : 1024;
                pg8::Gemm g{HB, (const bf16_t*)(ws + W_BIN) + (size_t)li * 1792 * 2048, M, N, 2048, 2048, 2048}; pg8::StaticOrder S; S.init(M, N, G, bx);
                EpiBIn E{PB, KR, SS, SSQ, SSL, COS, SIN};
                pg8::gemm_phase(lds, g, S, E, wave);
            }
            SEAM(pb);
        }
        if (!isA && IN(pb + 1)) {
            { pg8::Gemm g{PB, (const bf16_t*)(ws + W_UQ) + (size_t)li * 2304 * 512, M, UQ_N, 512, PB_LD, 512}; pg8::StaticOrder S; S.init(M, UQ_N, G, bx);
              EpiUq E{QB, SSQ, COS, SIN};
              pg8::gemm_phase(lds, g, S, E, wave); }
            if (L == 2) {
                pg8::Gemm g{PB + 1024, (const bf16_t*)(ws + W_UKV), M, UKV_N, 512, PB_LD, 512}; pg8::StaticOrder S; S.init(M, UKV_N, G, bx);
                EpiScaleBf16<2> E{KV, KVLD, SSL};
                pg8::gemm_phase(lds, g, S, E, wave);
            }
            SEAM(pb + 1);
        }
        if (IN(pb + 2)) {
          for (int rep = 0; rep < PROBE_ATT; ++rep) {
            for (int rep2 = 0; rep2 < PROBE_ATT_MAIN; ++rep2)
            for (int p = vcu; p < BATCH * NH * 4; p += G) {
                const int xx = p & 3, bh = p >> 2, b = bh / NH, h = bh - b * NH;
                for (int half = 0; half < 2; ++half) {
                    const int xq = half ? (7 - xx) : xx;
                    const size_t tok0 = (size_t)b * SEQ, tq = tok0 + (size_t)xq * 256;
                    if (isA) {
                        att::Args a{PROJ + tq * A_IN + h * 128, A_IN, PROJ + tok0 * A_IN + 1536 + h * 128, A_IN, nullptr, 0,
                                    PROJ + tok0 * A_IN + 3072 + h * 128, A_IN, MIX + tq * DM + h * 128, DM, xq * 256, 4 * (xq + 1), wave};
                        att::attn_unit<0, 128>(lds, a);
                    } else {
                        att::Args a{QB + tq * UQ_N + h * 192, UQ_N, KV + tok0 * KVLD + h * 256, KVLD, KR + tok0 * 64, 64,
                                    KV + tok0 * KVLD + h * 256 + 128, KVLD, MIX + tq * DM + h * 128, DM, xq * 256, 4 * (xq + 1), wave};
                        att::attn_unit<1, 192>(lds, a);
                    }
                }
            }
            for (int rep2 = 0; rep2 < PROBE_ATT_MEM; ++rep2)
            for (int p = vcu; p < BATCH * MEMH * 8; p += G) {
                const int xq = p & 7, bh = p >> 3, b = bh >> 2, h = bh & 3;
                const size_t tq = (size_t)b * SEQ + (size_t)xq * 256;
                const bf16_t* Qp = isA ? (PROJ + tq * A_IN + 4608 + h * 128) : (PB + tq * PB_LD + 512 + h * 128);
                const bf16_t* Kp = MEMKV + (size_t)(b * MEML) * 4096 + L * 1024 + h * 128;
                att::Args a{Qp, isA ? A_IN : PB_LD, Kp, 4096, nullptr, 0, Kp + 512, 4096, MIX + tq * DM + 1536 + h * 128, DM, 0, 4, wave};
                att::attn_unit<2, 128>(lds, a);
            }
            __syncthreads();
          }
            SEAM(pb + 2);
        }
        if (IN(pb + 3)) {
            const bf16_t* Wt = (const bf16_t*)(ws + (isA ? W_AOUT : W_BOUT)) + (size_t)li * 2048 * 2048;
            pg8::Gemm g{MIX, Wt, M, DM, 2048, 2048, 2048}; pg8::StaticOrder S; S.init(M, DM, G, bx);
            if (PROBE_NULL_OUT) { EpiNull E0{SSQ}; pg8::gemm_phase(lds, g, S, E0, wave); }
            EpiResid<false, false> E{x, out, HB, SS, (LAS float*)(lds + LDSCTL_OFF + 2048)};
            pg8::gemm_phase(lds, g, S, E, wave);
            SEAM(pb + 3);
        }
        if (IN(pb + 4)) {
            pg8::Gemm g{HB, (const bf16_t*)(ws + W_GU) + (size_t)L * 11264 * 2048, M, 2 * FFN, 2048, 2048, 2048}; pg8::StaticOrder S; S.init(M, 2 * FFN, G, bx);
#if PROBE_SPLIT_GU
            { pg8::Gemm g1 = g; g1.N = FFN; pg8::StaticOrder S1; S1.init(M, FFN, G, bx); EpiSwiglu E1{HID, SS, 0};
              pg8::gemm_phase(lds, g1, S1, E1, wave);
              xcd_barrier(bar);
              pg8::Gemm g2 = g1; g2.Bt = g.Bt + (size_t)FFN * 2048; EpiSwiglu E2{HID, SS, FFN / 2};
              pg8::gemm_phase(lds, g2, S1, E2, wave); }
#else
            EpiSwiglu E{HID, SS, 0};
            pg8::gemm_phase(lds, g, S, E, wave);
            if (PROBE_GU > 1) pg8::gemm_phase(lds, g, S, E, wave);
#endif
            SEAM(pb + 4);
        }
        if (IN(pb + 5)) {
            pg8::Gemm g{HID, (const bf16_t*)(ws + W_DN) + (size_t)L * 2048 * 5632, M, DM, FFN, FFN, FFN}; pg8::StaticOrder S; S.init(M, DM, G, bx);
            if (PROBE_NULL_DN) { EpiNull E0{SSQ}; pg8::gemm_phase(lds, g, S, E0, wave); }
            EpiResid<false, false> E{x, out, HB, SS, (LAS float*)(lds + LDSCTL_OFF + 2048)};
            pg8::gemm_phase(lds, g, S, E, wave);
            SEAM(pb + 5);
        }
    }
}
#undef IN
#undef SEAM
__global__ void __launch_bounds__(512, 2) yoco_fwd(KArgs args) {
    extern __shared__ __attribute__((aligned(16))) unsigned char lds_raw[];
    LAS unsigned char* lds = (LAS unsigned char*)lds_raw;
    volatile LAS unsigned* MISC = (volatile LAS unsigned*)(lds + MISC_OFF);
    const int wave = __builtin_amdgcn_readfirstlane((int)threadIdx.x >> 6);
    const int tid = MY_TID(wave), lane = tid & 63;
    const int G = gridDim.x, bx = blockIdx.x;
    const int vcu = (G % 8 == 0) ? (bx % 8) * (G / 8) + bx / 8 : bx;
    unsigned char* ws = args.ws;
    unsigned* ctl = (unsigned*)(ws + WS_CTL);
    for (int u = tid; u < (LDS_BYTES - LDSCTL_OFF) / 4; u += 512) ((LAS unsigned*)(lds + LDSCTL_OFF))[u] = 0u;
    __syncthreads();
    const int lo = args.ph_lo, hi = args.ph_hi;
    XcdBarrier bar; bar.bar = ctl + CW_BAR; bar.x = 0; bar.st = MISC + 8; bar.wave = wave;
    if (hi - lo > 1) bar = xcd_barrier_post(ctl + CW_BAR, MISC + 8, wave);
#define IN(k) (lo <= (k) && (k) < hi)
#define SEAM(k) do { if ((k) + 1 < hi) xcd_barrier(bar); } while (0)

    const float* x = (const float*)args.in[0];
    float* out = args.out;
    float* SS = (float*)(ws + WS_SS); float* SSQ = (float*)(ws + WS_SSQ); float* SSL = (float*)(ws + WS_SSL);
    float* COS = (float*)(ws + WS_COS); float* SIN = (float*)(ws + WS_SIN);
    bf16_t* HB = (bf16_t*)(ws + WS_HB); bf16_t* KV = (bf16_t*)(ws + WS_KV); bf16_t* KR = (bf16_t*)(ws + WS_KR);
    bf16_t* MEMKV = (bf16_t*)(ws + WS_MEMKV); bf16_t* MEMN = (bf16_t*)(ws + WS_MEMN);
    bf16_t* PROJ = (bf16_t*)(ws + WS_PROJ); bf16_t* PB = (bf16_t*)(ws + WS_PB); bf16_t* QB = (bf16_t*)(ws + WS_Q);
    bf16_t* MIX = (bf16_t*)(ws + WS_MIX); bf16_t* HID = (bf16_t*)(ws + WS_HID);
    const int gw = vcu * 8 + wave, NGW = G * 8;

    if (IN(0)) {
      for (int rep = 0; rep < PROBE_PRO; ++rep) {
        LAS float* scr = (LAS float*)(lds + wave * 16384);
        { f32x4 va[8], vb[8]; int ja = 0, la = 0, jbn = 0, lb = 0;
          int gi = gw; bool ha = cvt_locate(gi, ja, la);
          if (ha) cvt_load(args, JOBS[ja], la, lane, va);
          while (ha) {
              const bool hb = cvt_locate(gi + NGW, jbn, lb);
              if (hb) cvt_load(args, JOBS[jbn], lb, lane, vb);
              cvt_store(args, JOBS[ja], la, scr, lane, va);
              if (!hb) break;
              gi += 2 * NGW; ha = cvt_locate(gi, ja, la);
              if (ha) cvt_load(args, JOBS[ja], la, lane, va);
              cvt_store(args, JOBS[jbn], lb, scr, lane, vb);
          } }
        { f32x4 va[8], vb[8];
          auto ldrow = [&](f32x4 (&v)[8], int m) { const f32x4* xr = (const f32x4*)(x + (size_t)m * DM) + lane;
#pragma unroll
              for (int j = 0; j < 8; ++j) v[j] = __builtin_nontemporal_load(xr + 64 * j); };
          auto strow = [&](const f32x4 (&v)[8], int m) { float s = 0.f;
#pragma unroll
              for (int j = 0; j < 8; ++j) s += sq4(v[j]);
              s = wave_sum(s);
              u32x2* o8 = (u32x2*)(HB + (size_t)m * DM) + lane;
#pragma unroll
              for (int j = 0; j < 8; ++j) { u32x2 w; w.x = pk2(v[j][0], v[j][1]); w.y = pk2(v[j][2], v[j][3]); o8[64 * j] = w; }
              if (lane < 8) SS[(size_t)m * 8 + lane] = (lane == 0) ? s : 0.f; };
          int m = gw; if (m < M) ldrow(va, m);
          while (m < M) {
              const int mn = m + NGW; if (mn < M) ldrow(vb, mn);
              strow(va, m);
              if (mn >= M) break;
              m = mn + NGW; if (m < M) ldrow(va, m);
              strow(vb, mn);
          } }
        { const float* mem = (const float*)args.in[1]; const float* mg = (const float*)args.in[11];
          for (int m = gw; m < MROWS; m += NGW) {
            const f32x4* xr = (const f32x4*)(mem + (size_t)m * DM) + lane; const f32x4* gr = (const f32x4*)mg + lane;
            f32x4 v[8]; float s = 0.f;
#pragma unroll
            for (int j = 0; j < 8; ++j) { v[j] = __builtin_nontemporal_load(xr + 64 * j); s += sq4(v[j]); }
            s = wave_sum(s); const float rstd = rsq(s * (1.0f / 2048.0f) + RMS_EPS);
            u32x2* o8 = (u32x2*)(MEMN + (size_t)m * DM) + lane;
#pragma unroll
            for (int j = 0; j < 8; ++j) { const f32x4 gg = gr[64 * j]; const f32x4 y = v[j] * rstd * gg; u32x2 w; w.x = pk2(y[0], y[1]); w.y = pk2(y[2], y[3]); o8[64 * j] = w; }
          } }
        { const int* pos = (const int*)args.in[2];
          for (int idx = (vcu * 512 + tid); idx < M * 32; idx += G * 512) {
            const int tok = idx >> 5, i = idx & 31;
            const float inv_freq = __builtin_amdgcn_exp2f((float)i * (-13.287712379549449f / 32.0f));
            const float ang = (float)pos[tok] * inv_freq;
            const double rev = (double)ang * 0.15915494309189535;
            const float fr_ = (float)(rev - floor(rev));
            COS[idx] = __builtin_amdgcn_cosf(fr_); SIN[idx] = __builtin_amdgcn_sinf(fr_);
          } }
      }
        SEAM(0);
    }

    { Ctx c{lds, ws, out, x, G, bx, vcu, lo, hi, wave, bar};
      layer_phases<0>(c); layer_phases<1>(c); layer_phases<2>(c); layer_phases<3>(c); }
    if (IN(25)) {
        const float* fg = (const float*)args.in[19];
        int tz = MY_TID(wave); asm volatile("" : "+v"(tz));
        const int lane = tz & 63, gw = vcu * 8 + (tz >> 6);
        { u32x2 wa[8], wb[8]; float sa = 0.f, sb = 0.f;
          auto ldrow = [&](u32x2 (&w)[8], float& s, int m) { s = (lane < 8) ? SS[(size_t)m * 8 + lane] : 0.f;
              const u32x2* hr = (const u32x2*)((const bf16_t*)(ws + WS_HB) + (size_t)m * DM) + lane;
#pragma unroll
              for (int j = 0; j < 8; ++j) w[j] = hr[64 * j]; };
          auto strow = [&](const u32x2 (&w)[8], float s, int m) { s = wave_sum(s); const float rstd = rsq(s * (1.0f / 2048.0f) + RMS_EPS);
              f32x4* xr = (f32x4*)(out + (size_t)m * DM) + lane; const f32x4* gr = (const f32x4*)fg + lane;
#pragma unroll
              for (int j = 0; j < 8; ++j) { const f32x4 v = (f32x4){__uint_as_float(w[j].x << 16), __uint_as_float(w[j].x & 0xffff0000u), __uint_as_float(w[j].y << 16), __uint_as_float(w[j].y & 0xffff0000u)};
                  __builtin_nontemporal_store(v * rstd * gr[64 * j], xr + 64 * j); } };
          int m = gw; if (m < M) ldrow(wa, sa, m);
          while (m < M) {
              const int mn = m + NGW; if (mn < M) ldrow(wb, sb, mn);
              strow(wa, sa, m);
              if (mn >= M) break;
              m = mn + NGW; if (m < M) ldrow(wa, sa, m);
              strow(wb, sb, mn);
          } }
    }
#undef IN
#undef SEAM
}

extern "C" void kernel_launch(void* const* d_in, const int* in_sizes, int n_in, void* d_out, int out_size, void* d_ws, size_t ws_size, hipStream_t stream) {
    static int grid = 0;
    if (grid == 0) {
        if (n_in != 20 || out_size != M * DM || ws_size < WS_END) { fprintf(stderr, "kernel_launch: unexpected shapes (n_in %d out %d ws %zu need %zu)\n", n_in, out_size, ws_size, (size_t)WS_END); grid = -1; return; }
        int dev = 0, cus = 0, per_cu = 0;
        if (hipGetDevice(&dev) != hipSuccess || hipDeviceGetAttribute(&cus, hipDeviceAttributeMultiprocessorCount, dev) != hipSuccess) { grid = -1; return; }
        if (hipFuncSetAttribute((const void*)yoco_fwd, hipFuncAttributeMaxDynamicSharedMemorySize, LDS_BYTES) != hipSuccess) { fprintf(stderr, "kernel_launch: hipFuncSetAttribute failed\n"); grid = -1; return; }
        if (hipOccupancyMaxActiveBlocksPerMultiprocessor(&per_cu, (const void*)yoco_fwd, 512, LDS_BYTES) != hipSuccess || per_cu < 1) { fprintf(stderr, "kernel_launch: occupancy query says %d\n", per_cu); (void)hipGetLastError(); }
        grid = cus;
    }
    if (grid < 0) return;
    (void)hipMemsetAsync((char*)d_ws + WS_CTL, 0, CTL_ZERO_BYTES, stream);
    KArgs a{};
    for (int i = 0; i < 20; ++i) a.in[i] = d_in[i];
    a.out = (float*)d_out; a.ws = (unsigned char*)d_ws;
#if MK_PER_PHASE
    for (int k = 0; k < 26; ++k) {
        if (k >= 1 && k <= 12 && ((k - 1) % 6) == 1) continue;
        a.ph_lo = k; a.ph_hi = k + 1;
        hipLaunchKernelGGL(yoco_fwd, dim3(grid), dim3(512), LDS_BYTES, stream, a);
    }
#else
    a.ph_lo = 0; a.ph_hi = 26;
    hipLaunchKernelGGL(yoco_fwd, dim3(grid), dim3(512), LDS_BYTES, stream, a);
#endif
    const hipError_t le = hipPeekAtLastError();
    if (le != hipSuccess) fprintf(stderr, "kernel_launch: launch failed: %s\n", hipGetErrorName(le));
}
```

```cpp
#include <hip/hip_runtime.h>
#include <cstdio>
#include <cstdint>

#ifndef MK_PER_PHASE
#define MK_PER_PHASE 0
#endif

#ifndef PROBE_ATT
#define PROBE_ATT 1
#endif
#ifndef PROBE_ATT_MAIN
#define PROBE_ATT_MAIN 1
#endif
#ifndef PROBE_ATT_MEM
#define PROBE_ATT_MEM 1
#endif
#ifndef PROBE_GU
#define PROBE_GU 1
#endif
#ifndef PROBE_PRO
#define PROBE_PRO 1
#endif
#ifndef PROBE_EPI
#define PROBE_EPI 1
#endif
#ifndef PROBE_NULL_DN
#define PROBE_NULL_DN 0
#endif
#ifndef PROBE_NULL_OUT
#define PROBE_NULL_OUT 0
#endif
#ifndef PROBE_NULL_AIN
#define PROBE_NULL_AIN 0
#endif
#ifndef PROBE_NULL_B
#define PROBE_NULL_B 0
#endif
#ifndef PROBE_EPI_WHICH
#define PROBE_EPI_WHICH 0
#endif
#ifndef PROBE_SPLIT_GU
#define PROBE_SPLIT_GU 0
#endif
#define LAS __attribute__((address_space(3)))
#define GAS __attribute__((address_space(1)))
typedef unsigned short bf16_t;
typedef short bf16x8 __attribute__((ext_vector_type(8)));
typedef short s16x4 __attribute__((ext_vector_type(4)));
typedef float f32x4 __attribute__((ext_vector_type(4)));
typedef float f32x16 __attribute__((ext_vector_type(16)));
typedef unsigned u32x4 __attribute__((ext_vector_type(4)));
typedef unsigned u32x2 __attribute__((ext_vector_type(2)));

constexpr int BATCH = 16, SEQ = 2048, DM = 2048, M = BATCH * SEQ;
constexpr int NH = 12, HD = 128, MEMH = 4, MEML = 256, MROWS = BATCH * MEML;
constexpr int FFN = 5632;
constexpr int A_IN = 5120, PB_LD = 1792, UQ_N = 2304, UKV_N = 3072, KVLD = 3072;
constexpr float RMS_EPS = 1e-6f;

constexpr size_t MiB = 1u << 20;
constexpr size_t WS_CTL = 0, CTL_ZERO_BYTES = 64 * 1024;
constexpr size_t WS_SS = 1 * MiB;
constexpr size_t WS_SSQ = 5 * MiB;
constexpr size_t WS_SSL = 6 * MiB;
constexpr size_t WS_COS = 7 * MiB;
constexpr size_t WS_SIN = 11 * MiB;
constexpr size_t WS_HB = 16 * MiB;
constexpr size_t WS_KV = 144 * MiB;
constexpr size_t WS_KR = 336 * MiB;
constexpr size_t WS_MEMKV = 340 * MiB;
constexpr size_t WS_MEMN = 372 * MiB;
constexpr size_t WS_BIG = 388 * MiB;
constexpr size_t WS_PROJ = WS_BIG;
constexpr size_t WS_PB = WS_BIG;
constexpr size_t WS_Q = WS_BIG + 112 * MiB;
constexpr size_t WS_MIX = WS_BIG + 320 * MiB;
constexpr size_t WS_HID = WS_BIG;
constexpr size_t WS_W = 836 * MiB;
constexpr size_t W_AIN = WS_W;
constexpr size_t W_AOUT = W_AIN + 40 * MiB;
constexpr size_t W_BIN = W_AOUT + 16 * MiB;
constexpr size_t W_UQ = W_BIN + 14 * MiB;
constexpr size_t W_BOUT = W_UQ + 5 * MiB;
constexpr size_t W_MEMKV = W_BOUT + 16 * MiB;
constexpr size_t W_UKV = W_MEMKV + 16 * MiB;
constexpr size_t W_GU = W_UKV + 3 * MiB;
constexpr size_t W_DN = W_GU + 176 * MiB;
constexpr size_t WS_END = W_DN + 88 * MiB;
static_assert(WS_HID + (size_t)M * FFN * 2 <= WS_W && WS_MIX + (size_t)M * DM * 2 <= WS_W, "ws map");
constexpr int CW_BAR = 4096;

constexpr int RING_BYTES = 131072;
constexpr int LDSCTL_OFF = RING_BYTES, MISC_OFF = LDSCTL_OFF + 320;
constexpr int LDS_BYTES = 147456;

__device__ __forceinline__ unsigned f2bf(float f) { unsigned u = __builtin_bit_cast(unsigned, f); return (u + 0x7fffu + ((u >> 16) & 1u)) >> 16; }
__device__ __forceinline__ unsigned pk2(float lo, float hi) { return f2bf(lo) | (f2bf(hi) << 16); }
__device__ __forceinline__ unsigned cvt_pk_bf16(float lo, float hi) { unsigned r; asm volatile("v_cvt_pk_bf16_f32 %0, %1, %2" : "=v"(r) : "v"(lo), "v"(hi)); return r; }
__device__ __forceinline__ int lane_id() { int l; asm volatile("v_mbcnt_lo_u32_b32 %0, -1, 0\n\tv_mbcnt_hi_u32_b32 %0, -1, %0" : "=v"(l)); return l; }
#define MY_TID(wave_) (((wave_) << 6) | lane_id())
__device__ __forceinline__ float wave_sum(float v) {
#pragma unroll
    for (int o = 1; o < 64; o <<= 1) v += __shfl_xor(v, o);
    return v;
}

namespace pg8 {
constexpr int BM = 256, BK = 64, HALF = 128, HTB = HALF * BK * 2, STAGE_BYTES = 8 * HTB, NXCD = 8, WGM = 4;
__host__ __device__ __forceinline__ int lds_byte(int r, int c) { const int st = (r >> 4) * 2 + (c >> 5), rr = r & 15, cc = c & 31, ob = rr * 64 + cc * 2; return st * 1024 + (ob ^ (((ob >> 9) & 1) << 5)); }
__host__ __device__ __forceinline__ void stage_rc(int b, int& R, int& C) { const int st = b / 1024, sb = b % 1024, swz = sb ^ (((sb >> 9) & 1) << 5); R = (st >> 1) * 16 + swz / 64; C = (st & 1) * 32 + (swz % 64) / 2; }
__host__ __device__ __forceinline__ int perm32(int rho) { const int n = rho >> 4, i = rho & 15; return 8 * (i >> 2) + 4 * n + (i & 3); }

struct Unit { int pm, pn; };
struct Gemm { const bf16_t* A; const bf16_t* Bt; int M, N, K, lda, ldb; };

struct StaticOrder {
    int nM, nN, nwg, G, c;
    struct Pos { int L, gid, rem; };
    __device__ bool step(Pos& p, Unit& u) const {
        p.L += G; if (p.L >= nwg) return false;
        const int nig = WGM * nN; p.rem += G >> 3;
        while (p.rem >= nig) { p.rem -= nig; ++p.gid; }
        u.pm = p.gid * WGM + (p.rem & (WGM - 1)); u.pn = p.rem / WGM; return true;
    }
    __device__ bool first(Pos& p, Unit& u) const {
        p.L = c; if (p.L >= nwg) return false;
        const int wgid = (p.L & 7) * (nwg >> 3) + (p.L >> 3), nig = WGM * nN;
        p.gid = wgid / nig; p.rem = wgid - p.gid * nig;
        u.pm = p.gid * WGM + (p.rem & (WGM - 1)); u.pn = p.rem / WGM; return true;
    }
    __device__ void init(int M_, int N_, int G_, int c_) { nM = M_ / BM; nN = N_ / BM; nwg = nM * nN; G = G_; c = c_; }
    __device__ bool next(int i, Unit& u) const {
        const long L = (long)i * G + c; if (L >= nwg) return false;
        int wgid = (int)L; { const int q = nwg / NXCD, r = nwg % NXCD, xcd = wgid % NXCD, off = wgid / NXCD; wgid = (xcd < r ? xcd * (q + 1) : r * (q + 1) + (xcd - r) * q) + off; }
        const int nig = WGM * nN, gid = wgid / nig, fm = gid * WGM, gsz = (nM - fm) < WGM ? (nM - fm) : WGM;
        u.pm = fm + ((wgid % nig) % gsz); u.pn = (wgid % nig) / gsz; return true;
    }
};

__device__ __forceinline__ const char* uptr(const char* p) {
    const unsigned long long v = (unsigned long long)p;
    const unsigned lo = (unsigned)__builtin_amdgcn_readfirstlane((int)(unsigned)v), hi = (unsigned)__builtin_amdgcn_readfirstlane((int)(unsigned)(v >> 32));
    return (const char*)(((unsigned long long)hi << 32) | lo);
}
template <int OFF> __device__ __forceinline__ f32x4 lds_rd128f(int addr) { f32x4 r; asm volatile("ds_read_b128 %0, %1 offset:%2" : "=&v"(r) : "v"(addr), "i"(OFF) : "memory"); return r; }
template <class Epi>
__device__ __forceinline__ void gemm_phase(LAS unsigned char* lds, const Gemm g, const StaticOrder& S, const Epi& E, const int wave) {
    int tid_ = MY_TID(wave); asm volatile("" : "+v"(tid_));
    const int tid = tid_, wid = __builtin_amdgcn_readfirstlane(tid >> 6), lane = tid & 63, wr = wid >> 2, wc = wid & 3, fr = lane & 15, fq = lane >> 4;
    const int K = g.K, nt = K / BK;
    unsigned voffA[2], voffB[2];
#pragma unroll
    for (int i = 0; i < 2; ++i) { int R, C; stage_rc(tid * 16 + i * 8192, R, C); const int Rb = (R & ~31) + perm32(R & 31);
        voffA[i] = (unsigned)(R * g.lda + C) * 2u; voffB[i] = (unsigned)(Rb * g.ldb + C) * 2u; }
    const size_t kstep = (size_t)(BK * 2);
    const size_t hstepA = (size_t)HALF * g.lda * 2, hstepB = (size_t)HALF * g.ldb * 2;
    const size_t tstepA = 2 * hstepA, tstepB = 2 * hstepB;
    const unsigned ldsw = (unsigned)wid * 1024u;
    const int aoff = lds_byte(wr * 64 + fr, fq * 8), boff = lds_byte(wc * 32 + fr, fq * 8);
#define PG8_SA(b, h) (((b) * 2 + (h)) * HTB)
#define PG8_SB(b, h) ((4 + (b) * 2 + (h)) * HTB)
#define PG8_STAGE(bufoff, gbase, voff) do { const char* gb__ = uptr((const char*)(gbase)); _Pragma("unroll") for (int _i = 0; _i < 2; ++_i) { asm volatile("" : "+v"((voff)[_i])); \
        __builtin_amdgcn_global_load_lds((const unsigned*)(gb__ + (voff)[_i]), (LAS unsigned*)(lds + (bufoff) + ldsw + _i * 8192), 16, 0, 0); } } while (0)
#define PG8_LDA(dst, b, h) do { _Pragma("unroll") for (int m = 0; m < 4; ++m) _Pragma("unroll") for (int k = 0; k < 2; ++k) dst[m][k] = *(const LAS bf16x8*)(lds + PG8_SA(b, h) + aoff + m * 2048 + k * 1024); } while (0)
#define PG8_LDB(dst, b, h) do { _Pragma("unroll") for (int n = 0; n < 2; ++n) _Pragma("unroll") for (int k = 0; k < 2; ++k) dst[n][k] = *(const LAS bf16x8*)(lds + PG8_SB(b, h) + boff + n * 2048 + k * 1024); } while (0)
#define PG8_MMA(ai, bj, At, Bt) do { __builtin_amdgcn_s_setprio(3); _Pragma("unroll") for (int m = 0; m < 4; ++m) _Pragma("unroll") for (int n = 0; n < 2; ++n) _Pragma("unroll") for (int k = 0; k < 2; ++k) \
        acc[ai][bj][m][n] = __builtin_amdgcn_mfma_f32_16x16x32_bf16(Bt[n][k], At[m][k], acc[ai][bj][m][n], 0, 0, 0); __builtin_amdgcn_s_setprio(0); } while (0)
#define PG8_MMAZ(ai, bj, At, Bt) do { __builtin_amdgcn_s_setprio(3); _Pragma("unroll") for (int m = 0; m < 4; ++m) _Pragma("unroll") for (int n = 0; n < 2; ++n) { \
        acc[ai][bj][m][n] = __builtin_amdgcn_mfma_f32_16x16x32_bf16(Bt[n][0], At[m][0], (f32x4){0.f, 0.f, 0.f, 0.f}, 0, 0, 0); \
        acc[ai][bj][m][n] = __builtin_amdgcn_mfma_f32_16x16x32_bf16(Bt[n][1], At[m][1], acc[ai][bj][m][n], 0, 0, 0); } __builtin_amdgcn_s_setprio(0); } while (0)
#define PG8_WAIT_V(n) asm volatile("s_waitcnt vmcnt(" #n ")" ::: "memory")
#define PG8_WAIT_L(n) asm volatile("s_waitcnt lgkmcnt(" #n ")" ::: "memory")
#define PG8_BAR __builtin_amdgcn_s_barrier()
#define PG8_SCHED __builtin_amdgcn_sched_barrier(0)
    Unit cur, nxt; int ui = 0;
    const bool incr = ((S.nwg | S.G) & 7) == 0 && (S.nM % WGM) == 0;
    StaticOrder::Pos pos;
    if (incr) { if (!S.first(pos, cur)) return; } else if (!S.next(0, cur)) return;
    constexpr int RS_LDS = LDSCTL_OFF + 8192;
#define PG8_RS_DMA(pm_) do { if constexpr (Epi::RSTD) { unsigned vo__ = (unsigned)tid * 16u; asm volatile("" : "+v"(vo__)); \
        __builtin_amdgcn_global_load_lds((const unsigned*)((const char*)E.rs_src() + (size_t)(pm_) * 8192 + vo__), (LAS unsigned*)(lds + RS_LDS + ldsw), 16, 0, 0); } } while (0)
    PG8_RS_DMA(cur.pm);
    f32x4 acc[2][2][4][2];
    bf16x8 At[4][2], B0[2][2], B1[2][2];
    const char* cA = (const char*)g.A + (size_t)cur.pm * tstepA; const char* cB = (const char*)g.Bt + (size_t)cur.pn * tstepB;
    PG8_STAGE(PG8_SB(0, 0), cB, voffB); PG8_STAGE(PG8_SB(0, 1), cB + hstepB, voffB); PG8_STAGE(PG8_SA(0, 0), cA, voffA); PG8_STAGE(PG8_SA(0, 1), cA + hstepA, voffA);
    PG8_STAGE(PG8_SB(1, 0), cB + kstep, voffB); PG8_STAGE(PG8_SA(1, 0), cA + kstep, voffA); PG8_STAGE(PG8_SB(1, 1), cB + hstepB + kstep, voffB);
    PG8_WAIT_V(6);
    if (wr == 1) PG8_BAR;
    PG8_BAR;
    for (;;) {
        const bool has_next = incr ? S.step(pos, nxt) : S.next(ui + 1, nxt);
        const char* nA = has_next ? (const char*)g.A + (size_t)nxt.pm * tstepA : cA; const char* nB = has_next ? (const char*)g.Bt + (size_t)nxt.pn * tstepB : cB;
#define PG8_ITER(MMA0_) do { \
            const bool last = (t == nt - 2); \
            const char* a1 = cA + (size_t)(t + 1) * kstep; \
            const char* a2 = last ? nA : cA + (size_t)(t + 2) * kstep; const char* b2 = last ? nB : cB + (size_t)(t + 2) * kstep; \
            const char* a3 = a2 + kstep; const char* b3 = b2 + kstep; \
            PG8_LDB(B0, 0, 0); PG8_LDB(B1, 0, 1); PG8_SCHED; PG8_LDA(At, 0, 0); PG8_STAGE(PG8_SA(1, 1), a1 + hstepA, voffA); \
            PG8_WAIT_V(8); PG8_WAIT_L(0); PG8_BAR; MMA0_(0, 0, At, B0); MMA0_(0, 1, At, B1); PG8_BAR; PG8_SCHED; \
            PG8_LDA(At, 0, 1); PG8_STAGE(PG8_SB(0, 0), b2, voffB); PG8_STAGE(PG8_SB(0, 1), b2 + hstepB, voffB); PG8_STAGE(PG8_SA(0, 0), a2, voffA); \
            PG8_WAIT_V(8); PG8_WAIT_L(0); PG8_BAR; MMA0_(1, 0, At, B0); MMA0_(1, 1, At, B1); PG8_BAR; PG8_SCHED; \
            PG8_LDB(B0, 1, 0); PG8_LDB(B1, 1, 1); PG8_SCHED; PG8_LDA(At, 1, 0); PG8_STAGE(PG8_SA(0, 1), a2 + hstepA, voffA); \
            PG8_WAIT_V(8); PG8_WAIT_L(0); PG8_BAR; PG8_MMA(0, 0, At, B0); PG8_MMA(0, 1, At, B1); PG8_BAR; PG8_SCHED; \
            PG8_LDA(At, 1, 1); PG8_STAGE(PG8_SB(1, 0), b3, voffB); PG8_STAGE(PG8_SB(1, 1), b3 + hstepB, voffB); PG8_STAGE(PG8_SA(1, 0), a3, voffA); \
            PG8_WAIT_V(8); PG8_WAIT_L(0); PG8_BAR; PG8_MMA(1, 0, At, B0); PG8_MMA(1, 1, At, B1); PG8_BAR; PG8_SCHED; } while (0)
        { const int t = 0; PG8_ITER(PG8_MMAZ); }
        for (int t = 2; t < nt; t += 2) PG8_ITER(PG8_MMA);
#undef PG8_ITER
        if (wr == 0) PG8_BAR;
        { int tz = MY_TID(wave); asm volatile("" : "+v"(tz));
          const int wid2 = tz >> 6, lane2 = tz & 63;
          if constexpr (Epi::RSTD) {
              float rs[8];
              { const int ra = (int)(uintptr_t)lds + RS_LDS + ((wid2 >> 2) * 64 + (lane2 & 15)) * 32;
                f32x4 sa[8], sb[8];
#define PG8_RS_RD(k, OFF) sa[k] = lds_rd128f<(OFF) * 32>(ra); sb[k] = lds_rd128f<(OFF) * 32 + 16>(ra)
                PG8_RS_RD(0, 0); PG8_RS_RD(1, 16); PG8_RS_RD(2, 32); PG8_RS_RD(3, 48); PG8_RS_RD(4, 128); PG8_RS_RD(5, 144); PG8_RS_RD(6, 160); PG8_RS_RD(7, 176);
#undef PG8_RS_RD
                asm volatile("s_waitcnt lgkmcnt(0)" : "+v"(sa[0]), "+v"(sa[1]), "+v"(sa[2]), "+v"(sa[3]), "+v"(sa[4]), "+v"(sa[5]), "+v"(sa[6]), "+v"(sa[7]),
                                                        "+v"(sb[0]), "+v"(sb[1]), "+v"(sb[2]), "+v"(sb[3]), "+v"(sb[4]), "+v"(sb[5]), "+v"(sb[6]), "+v"(sb[7]) :: "memory");
#pragma unroll
                for (int k = 0; k < 8; ++k) { const float s = ((sa[k].x + sa[k].y) + (sa[k].z + sa[k].w)) + ((sb[k].x + sb[k].y) + (sb[k].z + sb[k].w)); rs[k] = __builtin_amdgcn_rsqf(s * Epi::INV_N + RMS_EPS); } }
              PG8_BAR;
              E.run_rs(acc, cur, wid2 >> 2, wid2 & 3, lane2 & 15, lane2 >> 4, rs);
              if (has_next) PG8_RS_DMA(nxt.pm);
          }
          else E(acc, cur, wid2 >> 2, wid2 & 3, lane2 & 15, lane2 >> 4);
          if (Epi::PROBE2 && PROBE_EPI > 1) { asm volatile("" : "+v"(tz)); const int wid3 = tz >> 6, lane3 = tz & 63; E.second(acc, cur, wid3 >> 2, wid3 & 3, lane3 & 15, lane3 >> 4); } }
        if (!has_next) break;
        cur = nxt; cA = nA; cB = nB; ++ui;
        if (wr == 1) PG8_BAR;
    }
    PG8_WAIT_V(0);
    PG8_BAR;
#undef PG8_RS_DMA
#undef PG8_SA
#undef PG8_SB
#undef PG8_STAGE
#undef PG8_LDA
#undef PG8_LDB
#undef PG8_MMA
#undef PG8_MMAZ
#undef PG8_WAIT_V
#undef PG8_WAIT_L
#undef PG8_BAR
#undef PG8_SCHED
}
}

__device__ __forceinline__ float rsq(float x) { return __builtin_amdgcn_rsqf(x); }
constexpr float QS128 = 0.08838834764831845f * 1.4426950408889634f;
constexpr float QS192 = 0.07216878364870322f * 1.4426950408889634f;
__device__ __forceinline__ void rstd8_8(const float* ss, int row0, float inv_n, float (&rs)[8]) {
#pragma unroll
    for (int h = 0; h < 2; ++h) {
        f32x4 a[4], b[4];
#pragma unroll
        for (int i = 0; i < 4; ++i) { const f32x4* p = (const f32x4*)(ss + (size_t)(row0 + h * 128 + i * 16) * 8); a[i] = p[0]; b[i] = p[1]; }
#pragma unroll
        for (int i = 0; i < 4; ++i) { const float s = ((a[i].x + a[i].y) + (a[i].z + a[i].w)) + ((b[i].x + b[i].y) + (b[i].z + b[i].w)); rs[h * 4 + i] = rsq(s * inv_n + RMS_EPS); }
        asm volatile("" : "+v"(rs[h * 4 + 0]), "+v"(rs[h * 4 + 1]), "+v"(rs[h * 4 + 2]), "+v"(rs[h * 4 + 3]));
    }
}
__device__ __forceinline__ void rs_issue(const float* ss, int row0, int h, f32x4 (&a)[4], f32x4 (&b)[4]) {
#pragma unroll
    for (int i = 0; i < 4; ++i) { const f32x4* p = (const f32x4*)(ss + (size_t)(row0 + h * 128 + i * 16) * 8); a[i] = p[0]; b[i] = p[1]; }
}
__device__ __forceinline__ void rs_finish(const f32x4 (&a)[4], const f32x4 (&b)[4], float inv_n, float* rs) {
#pragma unroll
    for (int i = 0; i < 4; ++i) { const float s = ((a[i].x + a[i].y) + (a[i].z + a[i].w)) + ((b[i].x + b[i].y) + (b[i].z + b[i].w)); rs[i] = rsq(s * inv_n + RMS_EPS); }
}
__device__ __forceinline__ u32x4 pack8(const f32x4 v0, const f32x4 v1) {
    u32x4 w; w.x = cvt_pk_bf16(v0[0], v0[1]); w.y = cvt_pk_bf16(v0[2], v0[3]); w.z = cvt_pk_bf16(v1[0], v1[1]); w.w = cvt_pk_bf16(v1[2], v1[3]); return w;
}
__device__ __forceinline__ float sq4(const f32x4 v) { return (v[0] * v[0] + v[1] * v[1]) + (v[2] * v[2] + v[3] * v[3]); }

template <int SRC> struct EpiScaleBf16 {
    static constexpr bool PROBE2 = (PROBE_EPI_WHICH == 1) && (SRC == 1), PREFETCH = false, RSTD = (SRC != 0);
    static constexpr float INV_N = (SRC == 1) ? 1.0f / 2048.0f : 1.0f / 512.0f;
    bf16_t* O; int ldc; const float* ss;
    __device__ __forceinline__ const float* rs_src() const { return ss; }
    __device__ __forceinline__ void run_rs(const f32x4 (&acc)[2][2][4][2], const pg8::Unit& u, int wr, int wc, int fr, int fq, const float (&rs)[8]) const { store(acc, u, wr, wc, fr, fq, rs, 0); store(acc, u, wr, wc, fr, fq, rs, 1); }
    __device__ __forceinline__ void rs_first(const pg8::Unit& u, int wr, int fr, float (&rs)[8]) const { rstd8_8(ss, u.pm * 256 + wr * 64 + fr, INV_N, rs); }
    __device__ __forceinline__ void second(const f32x4 (&acc)[2][2][4][2], const pg8::Unit& u, int wr, int wc, int fr, int fq) const { float rs[8]; rs_first(u, wr, fr, rs); store(acc, u, wr, wc, fr, fq, rs, 0); store(acc, u, wr, wc, fr, fq, rs, 1); }
    __device__ __forceinline__ void store(const f32x4 (&acc)[2][2][4][2], const pg8::Unit& u, int wr, int wc, int fr, int fq, const float (&rs)[8], const int ai) const {
        const int row0 = u.pm * 256 + wr * 64 + fr, col0 = u.pn * 256 + wc * 32 + 8 * fq;
        const float qs = (SRC == 1 && (u.pn < 6 || u.pn >= 18)) ? QS128 : 1.0f;
#pragma unroll
        for (int m = 0; m < 4; ++m) { bf16_t* rowp = O + (size_t)(row0 + ai * 128 + m * 16) * ldc + col0; const float s = SRC ? rs[ai * 4 + m] * qs : 1.0f;
#pragma unroll
            for (int bj = 0; bj < 2; ++bj) *(u32x4*)(rowp + bj * 128) = pack8(acc[ai][bj][m][0] * s, acc[ai][bj][m][1] * s); }
    }
    __device__ __forceinline__ void operator()(const f32x4 (&acc)[2][2][4][2], const pg8::Unit& u, int wr, int wc, int fr, int fq) const {
        float rs[8]; if (SRC) rs_first(u, wr, fr, rs); store(acc, u, wr, wc, fr, fq, rs, 0); store(acc, u, wr, wc, fr, fq, rs, 1);
    }
    __device__ __forceinline__ void run(const f32x4 (&acc)[2][2][4][2], const pg8::Unit& u, int wr, int wc, int fr, int fq, const float (&rs)[8], bool has_next, const pg8::Unit& nx, float (&rsn)[8]) const {
        const int nrow0 = nx.pm * 256 + wr * 64 + fr;
        f32x4 na[4], nb[4];
        if (has_next) rs_issue(ss, nrow0, 0, na, nb);
        store(acc, u, wr, wc, fr, fq, rs, 0);
        if (has_next) { rs_finish(na, nb, INV_N, &rsn[0]); asm volatile("" : "+v"(rsn[0]), "+v"(rsn[1]), "+v"(rsn[2]), "+v"(rsn[3])); rs_issue(ss, nrow0, 1, na, nb); }
        store(acc, u, wr, wc, fr, fq, rs, 1);
        if (has_next) { rs_finish(na, nb, INV_N, &rsn[4]); asm volatile("" : "+v"(rsn[4]), "+v"(rsn[5]), "+v"(rsn[6]), "+v"(rsn[7])); }
    }
};
__device__ __forceinline__ f32x4 bf2f_lo(const u32x4 w) { return (f32x4){__uint_as_float(w.x << 16), __uint_as_float(w.x & 0xffff0000u), __uint_as_float(w.y << 16), __uint_as_float(w.y & 0xffff0000u)}; }
__device__ __forceinline__ f32x4 bf2f_hi(const u32x4 w) { return (f32x4){__uint_as_float(w.z << 16), __uint_as_float(w.z & 0xffff0000u), __uint_as_float(w.w << 16), __uint_as_float(w.w & 0xffff0000u)}; }
template <bool INF32, bool OUTF32> struct EpiResid {
    static constexpr bool PROBE2 = (PROBE_EPI_WHICH == 2) && !INF32 && !OUTF32, PREFETCH = false, RSTD = false;
    const float* hin; float* hout; bf16_t* hb; float* ss; LAS float* red;
    __device__ __forceinline__ void operator()(const f32x4 (&acc)[2][2][4][2], const pg8::Unit& u, int wr, int wc, int fr, int fq) const { run(acc, u, wr, wc, fr, fq, 1.0f); }
    __device__ __forceinline__ void second(const f32x4 (&acc)[2][2][4][2], const pg8::Unit& u, int wr, int wc, int fr, int fq) const { run(acc, u, wr, wc, fr, fq, 0.0f); }
    __device__ __forceinline__ void run(const f32x4 (&acc)[2][2][4][2], const pg8::Unit& u, int wr, int wc, int fr, int fq, const float sc) const {
        const int row0 = u.pm * 256 + wr * 64 + fr, col0 = u.pn * 256 + wc * 32 + 8 * fq;
        constexpr int NB = INF32 ? 2 : 1, AB = 2 / NB;
#pragma unroll
        for (int b = 0; b < NB; ++b) {
            u32x4 hw[AB][4][2]; f32x4 ha[AB][4][2], hc[AB][4][2];
#pragma unroll
            for (int a2 = 0; a2 < AB; ++a2)
#pragma unroll
                for (int m = 0; m < 4; ++m)
#pragma unroll
                    for (int bj = 0; bj < 2; ++bj) { const int ai = b * AB + a2; const size_t off = (size_t)(row0 + ai * 128 + m * 16) * DM + col0 + bj * 128;
                        if (INF32) { ha[a2][m][bj] = *(const f32x4*)(hin + off); hc[a2][m][bj] = *(const f32x4*)(hin + off + 4); }
                        else hw[a2][m][bj] = *(const u32x4*)(hb + off); }
#pragma unroll
            for (int a2 = 0; a2 < AB; ++a2) { const int ai = b * AB + a2;
#pragma unroll
                for (int m = 0; m < 4; ++m) { const int row = row0 + ai * 128 + m * 16; const size_t off = (size_t)row * DM + col0; float q = 0.f;
#pragma unroll
                    for (int bj = 0; bj < 2; ++bj) {
                        const f32x4 r0 = INF32 ? ha[a2][m][bj] : bf2f_lo(hw[a2][m][bj]), r1 = INF32 ? hc[a2][m][bj] : bf2f_hi(hw[a2][m][bj]);
                        const f32x4 v0 = PROBE2 ? r0 + acc[ai][bj][m][0] * sc : r0 + acc[ai][bj][m][0], v1 = PROBE2 ? r1 + acc[ai][bj][m][1] * sc : r1 + acc[ai][bj][m][1];
                        if (OUTF32) { *(f32x4*)(hout + off + bj * 128) = v0; *(f32x4*)(hout + off + bj * 128 + 4) = v1; }
                        else *(u32x4*)(hb + off + bj * 128) = pack8(v0, v1);
                        q += sq4(v0) + sq4(v1); }
                    q += __shfl_xor(q, 16); q += __shfl_xor(q, 32);
                    if (fq == 0) red[(ai * 128 + wr * 64 + m * 16 + fr) * 4 + wc] = q; }
            }
        }
        asm volatile("s_waitcnt lgkmcnt(0)" ::: "memory"); __builtin_amdgcn_s_barrier(); asm volatile("" ::: "memory");
        int tz = ((wr * 4 + wc) << 6) | (fq * 16 + fr); asm volatile("" : "+v"(tz));
        if (tz < 256) { const f32x4 r = *(const LAS f32x4*)(red + tz * 4); ss[(size_t)(u.pm * 256 + tz) * 8 + u.pn] = (r.x + r.y) + (r.z + r.w); }
    }
};
struct EpiSwiglu {
    static constexpr bool PROBE2 = (PROBE_EPI_WHICH == 0), PREFETCH = false, RSTD = true;
    static constexpr float INV_N = 1.0f / 2048.0f;
    bf16_t* H; const float* ss; int coloff;
    __device__ __forceinline__ const float* rs_src() const { return ss; }
    __device__ __forceinline__ void run_rs(const f32x4 (&acc)[2][2][4][2], const pg8::Unit& u, int wr, int wc, int fr, int fq, const float (&rs)[8]) const { half(acc, u, wr, wc, fr, fq, rs, 0); half(acc, u, wr, wc, fr, fq, rs, 1); }
    __device__ __forceinline__ void rs_first(const pg8::Unit& u, int wr, int fr, float (&rs)[8]) const { rstd8_8(ss, u.pm * 256 + wr * 64 + fr, 1.0f / 2048.0f, rs); }
    __device__ __forceinline__ void second(const f32x4 (&acc)[2][2][4][2], const pg8::Unit& u, int wr, int wc, int fr, int fq) const { float rs[8]; rs_first(u, wr, fr, rs); half(acc, u, wr, wc, fr, fq, rs, 0); half(acc, u, wr, wc, fr, fq, rs, 1); }
    __device__ __forceinline__ void operator()(const f32x4 (&acc)[2][2][4][2], const pg8::Unit& u, int wr, int wc, int fr, int fq) const { second(acc, u, wr, wc, fr, fq); }
    __device__ __forceinline__ void half(const f32x4 (&acc)[2][2][4][2], const pg8::Unit& u, int wr, int wc, int fr, int fq, const float (&rs)[8], const int ai) const {
        const int row0 = u.pm * 256 + wr * 64 + fr, col0 = coloff + u.pn * 128 + wc * 32 + 8 * fq;
#pragma unroll
        for (int m = 0; m < 4; ++m) { const float s = rs[ai * 4 + m], sn = s * -1.4426950408889634f, s2 = s * s; f32x4 o[2];
#pragma unroll
            for (int n = 0; n < 2; ++n) { const f32x4 g = acc[ai][0][m][n]; const f32x4 t = g * sn; const f32x4 gu = g * acc[ai][1][m][n]; f32x4 r;
#pragma unroll
                for (int j = 0; j < 4; ++j) r[j] = __builtin_amdgcn_rcpf(1.0f + __builtin_amdgcn_exp2f(t[j]));
                o[n] = gu * (r * s2); }
            __builtin_nontemporal_store(pack8(o[0], o[1]), (u32x4*)(H + (size_t)(row0 + ai * 128 + m * 16) * FFN + col0)); }
    }
    __device__ __forceinline__ void run(const f32x4 (&acc)[2][2][4][2], const pg8::Unit& u, int wr, int wc, int fr, int fq, const float (&rs)[8], bool has_next, const pg8::Unit& nx, float (&rsn)[8]) const {
        const int nrow0 = nx.pm * 256 + wr * 64 + fr;
        f32x4 na[4], nb[4];
        if (has_next) rs_issue(ss, nrow0, 0, na, nb);
        half(acc, u, wr, wc, fr, fq, rs, 0);
        if (has_next) { rs_finish(na, nb, 1.0f / 2048.0f, &rsn[0]); asm volatile("" : "+v"(rsn[0]), "+v"(rsn[1]), "+v"(rsn[2]), "+v"(rsn[3])); rs_issue(ss, nrow0, 1, na, nb); }
        half(acc, u, wr, wc, fr, fq, rs, 1);
        if (has_next) { rs_finish(na, nb, 1.0f / 2048.0f, &rsn[4]); asm volatile("" : "+v"(rsn[4]), "+v"(rsn[5]), "+v"(rsn[6]), "+v"(rsn[7])); }
    }
};
struct EpiNull {
    static constexpr bool PROBE2 = false, PREFETCH = false, RSTD = false;
    __device__ __forceinline__ void second(const f32x4 (&acc)[2][2][4][2], const pg8::Unit& u, int wr, int wc, int fr, int fq) const {}
    float* sink;
    __device__ __forceinline__ void operator()(const f32x4 (&acc)[2][2][4][2], const pg8::Unit& u, int wr, int wc, int fr, int fq) const {
        f32x4 s = (f32x4){0.f, 0.f, 0.f, 0.f};
#pragma unroll
        for (int ai = 0; ai < 2; ++ai)
#pragma unroll
            for (int bj = 0; bj < 2; ++bj)
#pragma unroll
                for (int m = 0; m < 4; ++m) { s += acc[ai][bj][m][0]; s += acc[ai][bj][m][1]; }
        const float t = (s.x + s.y) + (s.z + s.w);
        if (t != t) sink[0] = t;
    }
};
__device__ __forceinline__ void rope4(f32x4& x1, f32x4& x2, const float* cosT, const float* sinT, int row, int i0) {
    const f32x4 c = *(const f32x4*)(cosT + (size_t)row * 32 + i0), s = *(const f32x4*)(sinT + (size_t)row * 32 + i0);
    const f32x4 o1 = x1 * c - x2 * s, o2 = x2 * c + x1 * s; x1 = o1; x2 = o2;
}
struct EpiBIn {
    static constexpr bool PROBE2 = false, PREFETCH = false, RSTD = true;
    static constexpr float INV_N = 1.0f / 2048.0f;
    __device__ __forceinline__ void second(const f32x4 (&acc)[2][2][4][2], const pg8::Unit& u, int wr, int wc, int fr, int fq) const {}
    bf16_t* pb; bf16_t* kr; const float* ss; float* ssq; float* ssl; const float* cosT; const float* sinT;
    __device__ __forceinline__ const float* rs_src() const { return ss; }
    __device__ __forceinline__ void run_rs(const f32x4 (&acc)[2][2][4][2], const pg8::Unit& u, int wr, int wc, int fr, int fq, const float (&rs)[8]) const {
        const int row0 = u.pm * 256 + wr * 64 + fr, col0 = u.pn * 256 + wc * 32 + 8 * fq, pn = u.pn;
        if (pn < 6) {
            const bool want = (pn < 2) || (pn >= 4); float* sqp = (pn < 2) ? ssq : ssl; const int slot = (pn & 1) * 4 + wc;
#pragma unroll
            for (int ai = 0; ai < 2; ++ai)
#pragma unroll
                for (int m = 0; m < 4; ++m) { const int row = row0 + ai * 128 + m * 16; const float s = rs[ai * 4 + m] * (want ? 1.0f : QS128); float q = 0.f;
#pragma unroll
                    for (int bj = 0; bj < 2; ++bj) { const f32x4 v0 = acc[ai][bj][m][0] * s, v1 = acc[ai][bj][m][1] * s;
                        *(u32x4*)(pb + (size_t)row * PB_LD + col0 + bj * 128) = pack8(v0, v1); q += sq4(v0) + sq4(v1); }
                    q += __shfl_xor(q, 16); q += __shfl_xor(q, 32);
                    if (want && fq == 0) sqp[(size_t)row * 8 + slot] = q; }
        } else if (wc < 2) {
            const int i0 = 4 * (4 * wc + fq);
#pragma unroll
            for (int ai = 0; ai < 2; ++ai)
#pragma unroll
                for (int m = 0; m < 4; ++m) { const int row = row0 + ai * 128 + m * 16; const float s = rs[ai * 4 + m];
                    f32x4 x1 = acc[ai][0][m][0] * s, x2 = acc[ai][0][m][1] * s; rope4(x1, x2, cosT, sinT, row, i0);
                    *(u32x4*)(kr + (size_t)row * 64 + wc * 32 + 8 * fq) = pack8(x1, x2); }
        }
    }
};
struct EpiUq {
    static constexpr bool PROBE2 = false, PREFETCH = false, RSTD = true;
    static constexpr float INV_N = 1.0f / 512.0f;
    __device__ __forceinline__ void second(const f32x4 (&acc)[2][2][4][2], const pg8::Unit& u, int wr, int wc, int fr, int fq) const {}
    bf16_t* q; const float* ssq; const float* cosT; const float* sinT;
    __device__ __forceinline__ const float* rs_src() const { return ssq; }
    __device__ __forceinline__ void run_rs(const f32x4 (&acc)[2][2][4][2], const pg8::Unit& u, int wr, int wc, int fr, int fq, const float (&rs)[8]) const {
        const int row0 = u.pm * 256 + wr * 64 + fr, col0 = u.pn * 256 + wc * 32 + 8 * fq;
        const int i0 = 4 * (4 * (wc & 1) + fq);
#pragma unroll
        for (int ai = 0; ai < 2; ++ai)
#pragma unroll
            for (int m = 0; m < 4; ++m) { const int row = row0 + ai * 128 + m * 16; const float s = rs[ai * 4 + m] * QS192;
#pragma unroll
                for (int bj = 0; bj < 2; ++bj) { f32x4 v0 = acc[ai][bj][m][0] * s, v1 = acc[ai][bj][m][1] * s;
                    const int gb = 4 * u.pn + 2 * bj + (wc >> 1);
                    if (gb % 3 == 2) rope4(v0, v1, cosT, sinT, row, i0);
                    *(u32x4*)(q + (size_t)row * UQ_N + col0 + bj * 128) = pack8(v0, v1); } }
    }
};

namespace att {
__device__ __forceinline__ int crow(int r, int hi) { return (r & 3) + 8 * (r >> 2) + 4 * hi; }
__device__ __forceinline__ int key2slot(int k) { const int hi = k >> 5, h = (k >> 4) & 1, r = k & 15; return 32 * h + (r & 3) + 8 * (r >> 2) + 4 * hi; }
__device__ __forceinline__ int slot2key(int s) { const int h = s >> 5, rho = s & 31, hi = (rho >> 2) & 1, r = (rho & 3) | ((rho >> 3) << 2); return 32 * hi + 16 * h + r; }
__device__ __forceinline__ int v_st(int k, int c) { const int kk = (k & ~0xC) | ((k & 4) << 1) | ((k & 8) >> 1); return ((kk >> 3) * 4 + (c >> 5)) * 512 + ((kk & 7) * 32 + (c & 31)) * 2; }
__device__ __forceinline__ int v_rd_base(int lane) { return ((lane & 3) << 3) | (((lane >> 2) & 3) << 6) | (((lane >> 4) & 1) << 5) | (((lane >> 5) & 1) << 8); }
constexpr int v_rd_off(int d0, int ks, int half) { return d0 * 512 + ks * 4096 + half * 2048; }
template <int OFF> __device__ __forceinline__ bf16x8 lds_rd128(int addr) { bf16x8 r; asm volatile("ds_read_b128 %0, %1 offset:%2" : "=&v"(r) : "v"(addr), "i"(OFF) : "memory"); return r; }
__device__ __forceinline__ float lds_rd32(int addr) { float r; asm volatile("ds_read_b32 %0, %1" : "=&v"(r) : "v"(addr) : "memory"); return r; }
__device__ __forceinline__ unsigned lds_rd32u(int addr) { unsigned r; asm volatile("ds_read_b32 %0, %1" : "=&v"(r) : "v"(addr) : "memory"); return r; }
__device__ __forceinline__ void lds_wr32(int addr, float v) { asm volatile("ds_write_b32 %0, %1" :: "v"(addr), "v"(v) : "memory"); }
__device__ __forceinline__ void lds_wr32u(int addr, unsigned v) { asm volatile("ds_write_b32 %0, %1" :: "v"(addr), "v"(v) : "memory"); }
#define ATT_LGKM0() asm volatile("s_waitcnt lgkmcnt(0)" ::: "memory")
template <int OFF> __device__ __forceinline__ s16x4 tr_read(int vb) {
    s16x4 r; asm volatile("ds_read_b64_tr_b16 %0, %1 offset:%2" : "=&v"(r) : "v"(vb), "i"(OFF) : "memory"); return r;
}
struct VFrag { s16x4 l0, h0, l1, h1, l2, h2, l3, h3; };
template <int D0> __device__ __forceinline__ void pv_issue(VFrag& f, int vb) {
    f.l0 = tr_read<v_rd_off(D0, 0, 0)>(vb); f.h0 = tr_read<v_rd_off(D0, 0, 1)>(vb); f.l1 = tr_read<v_rd_off(D0, 1, 0)>(vb); f.h1 = tr_read<v_rd_off(D0, 1, 1)>(vb);
    f.l2 = tr_read<v_rd_off(D0, 2, 0)>(vb); f.h2 = tr_read<v_rd_off(D0, 2, 1)>(vb); f.l3 = tr_read<v_rd_off(D0, 3, 0)>(vb); f.h3 = tr_read<v_rd_off(D0, 3, 1)>(vb);
}
template <int N> __device__ __forceinline__ void pv_wait(VFrag& f) {
    asm volatile("s_waitcnt lgkmcnt(%8)" : "+v"(f.l0), "+v"(f.h0), "+v"(f.l1), "+v"(f.h1), "+v"(f.l2), "+v"(f.h2), "+v"(f.l3), "+v"(f.h3) : "i"(N) : "memory");
    __builtin_amdgcn_sched_barrier(0);
}
__device__ __forceinline__ void pv_mma(f32x16& od, const VFrag& f, bf16x8 pb0, bf16x8 pb1, bf16x8 pb2, bf16x8 pb3) {
#define ATT_PK(L, H) (bf16x8){L[0], L[1], L[2], L[3], H[0], H[1], H[2], H[3]}
    od = __builtin_amdgcn_mfma_f32_32x32x16_bf16(ATT_PK(f.l0, f.h0), pb0, od, 0, 0, 0);
    od = __builtin_amdgcn_mfma_f32_32x32x16_bf16(ATT_PK(f.l1, f.h1), pb1, od, 0, 0, 0);
    od = __builtin_amdgcn_mfma_f32_32x32x16_bf16(ATT_PK(f.l2, f.h2), pb2, od, 0, 0, 0);
    od = __builtin_amdgcn_mfma_f32_32x32x16_bf16(ATT_PK(f.l3, f.h3), pb3, od, 0, 0, 0);
#undef ATT_PK
    __builtin_amdgcn_sched_barrier(0);
}
__device__ __forceinline__ void pv_tile(f32x16 (&o)[4], int vb, bf16x8 pa0, bf16x8 pa1, bf16x8 pa2, bf16x8 pa3) {
    VFrag x, y;
    pv_issue<0>(x, vb); pv_issue<1>(y, vb);
    pv_wait<8>(x); pv_mma(o[0], x, pa0, pa1, pa2, pa3); pv_issue<2>(x, vb);
    pv_wait<8>(y); pv_mma(o[1], y, pa0, pa1, pa2, pa3); pv_issue<3>(y, vb);
    pv_wait<8>(x); pv_mma(o[2], x, pa0, pa1, pa2, pa3);
    pv_wait<0>(y); pv_mma(o[3], y, pa0, pa1, pa2, pa3);
}
__device__ __forceinline__ float sum16(const f32x16& p) {
    float a, b;
    asm volatile("s_nop 0\n\t"
                 "v_add_f32 %0, %2, %3\n\tv_add_f32 %1, %4, %5\n\t"
                 "v_add_f32 %0, %0, %6\n\tv_add_f32 %1, %1, %7\n\t"
                 "v_add_f32 %0, %0, %8\n\tv_add_f32 %1, %1, %9\n\t"
                 "v_add_f32 %0, %0, %10\n\tv_add_f32 %1, %1, %11\n\t"
                 "v_add_f32 %0, %0, %12\n\tv_add_f32 %1, %1, %13\n\t"
                 "v_add_f32 %0, %0, %14\n\tv_add_f32 %1, %1, %15\n\t"
                 "v_add_f32 %0, %0, %16\n\tv_add_f32 %1, %1, %17"
                 : "=&v"(a), "=&v"(b)
                 : "v"(p[0]), "v"(p[1]), "v"(p[2]), "v"(p[3]), "v"(p[4]), "v"(p[5]), "v"(p[6]), "v"(p[7]),
                   "v"(p[8]), "v"(p[9]), "v"(p[10]), "v"(p[11]), "v"(p[12]), "v"(p[13]), "v"(p[14]), "v"(p[15]));
    return a + b;
}
__device__ __forceinline__ void add1_16(f32x16& p) {
    float e0 = p[0], e1 = p[1], e2 = p[2], e3 = p[3], e4 = p[4], e5 = p[5], e6 = p[6], e7 = p[7], e8 = p[8], e9 = p[9], e10 = p[10], e11 = p[11], e12 = p[12], e13 = p[13], e14 = p[14], e15 = p[15];
    asm volatile("s_nop 0\n\t"
                 "v_add_f32 %0, 1.0, %0\n\tv_add_f32 %1, 1.0, %1\n\tv_add_f32 %2, 1.0, %2\n\tv_add_f32 %3, 1.0, %3\n\t"
                 "v_add_f32 %4, 1.0, %4\n\tv_add_f32 %5, 1.0, %5\n\tv_add_f32 %6, 1.0, %6\n\tv_add_f32 %7, 1.0, %7\n\t"
                 "v_add_f32 %8, 1.0, %8\n\tv_add_f32 %9, 1.0, %9\n\tv_add_f32 %10, 1.0, %10\n\tv_add_f32 %11, 1.0, %11\n\t"
                 "v_add_f32 %12, 1.0, %12\n\tv_add_f32 %13, 1.0, %13\n\tv_add_f32 %14, 1.0, %14\n\tv_add_f32 %15, 1.0, %15"
                 : "+v"(e0), "+v"(e1), "+v"(e2), "+v"(e3), "+v"(e4), "+v"(e5), "+v"(e6), "+v"(e7), "+v"(e8), "+v"(e9), "+v"(e10), "+v"(e11), "+v"(e12), "+v"(e13), "+v"(e14), "+v"(e15));
    p = (f32x16){e0, e1, e2, e3, e4, e5, e6, e7, e8, e9, e10, e11, e12, e13, e14, e15};
}
__device__ __forceinline__ void diff16(f32x16& p, float& prev) {
    float e0 = p[0], e1 = p[1], e2 = p[2], e3 = p[3], e4 = p[4], e5 = p[5], e6 = p[6], e7 = p[7], e8 = p[8], e9 = p[9], e10 = p[10], e11 = p[11], e12 = p[12], e13 = p[13], e14 = p[14], e15 = p[15];
    float nprev;
    asm volatile("s_nop 0\n\t"
                 "v_mov_b32 %16, %0\n\t"
                 "v_sub_f32 %0, %1, %0\n\tv_sub_f32 %1, %2, %1\n\tv_sub_f32 %2, %3, %2\n\tv_sub_f32 %3, %4, %3\n\t"
                 "v_sub_f32 %4, %5, %4\n\tv_sub_f32 %5, %6, %5\n\tv_sub_f32 %6, %7, %6\n\tv_sub_f32 %7, %8, %7\n\t"
                 "v_sub_f32 %8, %9, %8\n\tv_sub_f32 %9, %10, %9\n\tv_sub_f32 %10, %11, %10\n\tv_sub_f32 %11, %12, %11\n\t"
                 "v_sub_f32 %12, %13, %12\n\tv_sub_f32 %13, %14, %13\n\tv_sub_f32 %14, %15, %14\n\tv_sub_f32 %15, %17, %15"
                 : "+v"(e0), "+v"(e1), "+v"(e2), "+v"(e3), "+v"(e4), "+v"(e5), "+v"(e6), "+v"(e7), "+v"(e8), "+v"(e9), "+v"(e10), "+v"(e11), "+v"(e12), "+v"(e13), "+v"(e14), "+v"(e15), "=&v"(nprev)
                 : "v"(prev));
    p = (f32x16){e0, e1, e2, e3, e4, e5, e6, e7, e8, e9, e10, e11, e12, e13, e14, e15};
    prev = nprev;
}
__device__ __forceinline__ void cumprod_hi(f32x16& a, f32x16& b) {
    float a8 = a[8], a9 = a[9], a10 = a[10], a11 = a[11], a12 = a[12], a13 = a[13], a14 = a[14], a15 = a[15], b8 = b[8], b9 = b[9], b10 = b[10], b11 = b[11], b12 = b[12], b13 = b[13], b14 = b[14], b15 = b[15];
    asm volatile("v_mul_f32 %6, %7, %6\n\tv_mul_f32 %14, %15, %14\n\tv_mul_f32 %5, %6, %5\n\tv_mul_f32 %13, %14, %13\n\t"
                 "v_mul_f32 %4, %5, %4\n\tv_mul_f32 %12, %13, %12\n\tv_mul_f32 %3, %4, %3\n\tv_mul_f32 %11, %12, %11\n\t"
                 "v_mul_f32 %2, %3, %2\n\tv_mul_f32 %10, %11, %10\n\tv_mul_f32 %1, %2, %1\n\tv_mul_f32 %9, %10, %9\n\t"
                 "v_mul_f32 %0, %1, %0\n\tv_mul_f32 %8, %9, %8"
                 : "+v"(a8), "+v"(a9), "+v"(a10), "+v"(a11), "+v"(a12), "+v"(a13), "+v"(a14), "+v"(a15), "+v"(b8), "+v"(b9), "+v"(b10), "+v"(b11), "+v"(b12), "+v"(b13), "+v"(b14), "+v"(b15));
    a[8] = a8; a[9] = a9; a[10] = a10; a[11] = a11; a[12] = a12; a[13] = a13; a[14] = a14; b[8] = b8; b[9] = b9; b[10] = b10; b[11] = b11; b[12] = b12; b[13] = b13; b[14] = b14;
}
__device__ __forceinline__ void cumprod_lo(f32x16& a, f32x16& b) {
    float a0 = a[0], a1 = a[1], a2 = a[2], a3 = a[3], a4 = a[4], a5 = a[5], a6 = a[6], a7 = a[7], b0 = b[0], b1 = b[1], b2 = b[2], b3 = b[3], b4 = b[4], b5 = b[5], b6 = b[6], b7 = b[7];
    asm volatile("v_mul_f32 %7, %16, %7\n\tv_mul_f32 %15, %17, %15\n\tv_mul_f32 %6, %7, %6\n\tv_mul_f32 %14, %15, %14\n\t"
                 "v_mul_f32 %5, %6, %5\n\tv_mul_f32 %13, %14, %13\n\tv_mul_f32 %4, %5, %4\n\tv_mul_f32 %12, %13, %12\n\t"
                 "v_mul_f32 %3, %4, %3\n\tv_mul_f32 %11, %12, %11\n\tv_mul_f32 %2, %3, %2\n\tv_mul_f32 %10, %11, %10\n\t"
                 "v_mul_f32 %1, %2, %1\n\tv_mul_f32 %9, %10, %9\n\tv_mul_f32 %0, %1, %0\n\tv_mul_f32 %8, %9, %8"
                 : "+v"(a0), "+v"(a1), "+v"(a2), "+v"(a3), "+v"(a4), "+v"(a5), "+v"(a6), "+v"(a7), "+v"(b0), "+v"(b1), "+v"(b2), "+v"(b3), "+v"(b4), "+v"(b5), "+v"(b6), "+v"(b7)
                 : "v"(a[8]), "v"(b[8]));
    a[0] = a0; a[1] = a1; a[2] = a2; a[3] = a3; a[4] = a4; a[5] = a5; a[6] = a6; a[7] = a7; b[0] = b0; b[1] = b1; b[2] = b2; b[3] = b3; b[4] = b4; b[5] = b5; b[6] = b6; b[7] = b7;
}
struct Args { const bf16_t* Q; int ldq; const bf16_t* K; int ldk; const bf16_t* Kr; int ldkr; const bf16_t* V; int ldv; bf16_t* O; int ldo; int q0; int ntiles; int wave; };

constexpr int AK_BUF = 24576, AV_OFF = 2 * AK_BUF, AV_BUF = 16384, AST_OFF = AV_OFF + 2 * AV_BUF, AFLAG_OFF = AST_OFF + 2048;
#define ATT_BAR() do { asm volatile("s_waitcnt lgkmcnt(0)" ::: "memory"); __builtin_amdgcn_s_barrier(); asm volatile("" ::: "memory"); } while (0)
template <int MODE, int DQK>
__device__ __forceinline__ void attn_unit(LAS unsigned char* lds, const Args& a) {
    constexpr int ND = DQK / 16;
    constexpr float THRS = 8.0f * 1.4426950408889634f;
    int tid_ = MY_TID(a.wave); asm volatile("" : "+v"(tid_));
    const int tid = tid_, wid = tid >> 6, lane = tid & 63, r32 = lane & 31, hi = lane >> 5;
    const int grp = __builtin_amdgcn_readfirstlane(wid >> 2);
    const int ldsb = (int)(uintptr_t)lds;
    const int st_a = ldsb + AST_OFF + wid * 256;
    const int fl_a = ldsb + AFLAG_OFF;
    bf16x8 qr[ND];
    { const bf16_t* Qw = a.Q + (size_t)(wid * 32 + r32) * a.ldq + hi * 8;
#pragma unroll
      for (int d0 = 0; d0 < ND; ++d0) qr[d0] = *(const bf16x8*)(Qw + d0 * 16); }
    f32x16 o[4];
#pragma unroll
    for (int d = 0; d < 4; ++d)
#pragma unroll
        for (int r = 0; r < 16; ++r) o[d][r] = 0.f;
    float l_reg = 0.f, carryP = 1.f;
    f32x16 nb;
#pragma unroll
    for (int r = 0; r < 16; ++r) nb[r] = 0.f;
    unsigned voffK[2], voffV[2], voffR;
#pragma unroll
    for (int i = 0; i < 2; ++i) {
        const int A = wid * 2048 + i * 1024 + lane * 16;
        { const int slot = A >> 8, ck = ((A >> 4) & 15) ^ (slot & 15); voffK[i] = (unsigned)(slot2key(slot) * a.ldk + ck * 8) * 2u; }
        { const int sub = A >> 9, within = (A & 511) >> 1, kk = ((sub >> 2) << 3) | (within >> 5), c = ((sub & 3) << 5) | (within & 31);
          const int slot = kk;
          voffV[i] = (unsigned)(slot2key(slot) * a.ldv + c) * 2u; }
    }
    { const int A = wid * 1024 + lane * 16, slot = A >> 7, ck = ((A >> 4) & 7) ^ ((slot >> 1) & 7); voffR = (unsigned)(slot2key(slot) * a.ldkr + ck * 8) * 2u; }
    const int kx = r32 & 15, kxr = (r32 >> 1) & 7;
    int koff[ND];
#pragma unroll
    for (int d0 = 0; d0 < ND; ++d0) { koff[d0] = (d0 < 8) ? (r32 * 256 + (((2 * d0 + hi) ^ kx) << 4)) : (16384 + r32 * 128 + (((2 * (d0 - 8) + hi) ^ kxr) << 4)); asm volatile("" : "+v"(koff[d0])); }
    const int vb0 = (int)(uintptr_t)lds + AV_OFF + v_rd_base(lane);
    const int qpos = a.q0 + wid * 32 + r32, qmax = a.q0 + wid * 32 + 31;
    const int nt0 = a.ntiles; int nt = nt0;
#define ATT_TILE(t_) (((MODE == 0) ? (nt0 - 1 - (t_)) : (t_)) * 64)
#define ATT_DMA(gp_, voff_, ldsoff_) do { asm volatile("" : "+v"(voff_)); __builtin_amdgcn_global_load_lds((const unsigned*)(pg8::uptr((const char*)(gp_)) + (voff_)), (LAS unsigned*)(lds + (ldsoff_)), 16, 0, 0); } while (0)
#define ATT_DMAK(t_) do { const int k0_ = ATT_TILE(t_); const int kb_ = ((t_) & 1) * AK_BUF; const bf16_t* kp_ = a.K + (size_t)k0_ * a.ldk; \
        ATT_DMA(kp_, voffK[0], kb_ + a.wave * 2048); ATT_DMA(kp_, voffK[1], kb_ + a.wave * 2048 + 1024); \
        if (DQK == 192) { const bf16_t* rp_ = a.Kr + (size_t)k0_ * a.ldkr; ATT_DMA(rp_, voffR, kb_ + 16384 + a.wave * 1024); } } while (0)
#define ATT_DMAV(t_) do { const int k0_ = ATT_TILE(t_); const int vo_ = AV_OFF + ((t_) & 1) * AV_BUF; const bf16_t* vp_ = a.V + (size_t)k0_ * a.ldv; \
        ATT_DMA(vp_, voffV[0], vo_ + a.wave * 2048); ATT_DMA(vp_, voffV[1], vo_ + a.wave * 2048 + 1024); } while (0)
    if (MODE == 0 && lane < 2) lds_wr32u(fl_a + (lane * 8 + wid) * 4, 0u);
    ATT_BAR();
    ATT_DMAK(0);
    asm volatile("s_waitcnt vmcnt(0)" ::: "memory");
    ATT_BAR();
#pragma unroll
    for (int d0 = 0; d0 < ND; ++d0) asm volatile("" : "+v"(qr[d0]));
    bool actQ = false, actP = false;
    f32x16 p0, p1;
    if (grp == 1) { if (1 < nt0) ATT_DMAK(1); ATT_DMAV(0); ATT_BAR(); }
    for (int t = 0; t <= nt; ++t) {
        if (grp == 0) { if (t + 1 < nt0) ATT_DMAK(t + 1); if (t < nt0) ATT_DMAV(t); }
        else if (MODE == 0 && t >= 1) {
            unsigned fw[8];
#pragma unroll
            for (int w = 0; w < 8; ++w) fw[w] = lds_rd32u(fl_a + (((t - 1) & 1) * 8 + w) * 4);
            asm volatile("s_waitcnt lgkmcnt(0)" : "+v"(fw[0]), "+v"(fw[1]), "+v"(fw[2]), "+v"(fw[3]), "+v"(fw[4]), "+v"(fw[5]), "+v"(fw[6]), "+v"(fw[7]) :: "memory");
            unsigned alld = 1u;
#pragma unroll
            for (int w = 0; w < 8; ++w) alld &= fw[w];
            if (__builtin_amdgcn_readfirstlane(alld) && t < nt) nt = t;
        }
        if (t >= 1 && actP) {
            const int vb = vb0 + ((t - 1) & 1) * AV_BUF;
            u32x4 w0_ = {__float_as_uint(p0[0]), __float_as_uint(p0[1]), __float_as_uint(p0[2]), __float_as_uint(p0[3])}, w1_ = {__float_as_uint(p0[4]), __float_as_uint(p0[5]), __float_as_uint(p0[6]), __float_as_uint(p0[7])};
            u32x4 w2_ = {__float_as_uint(p0[8]), __float_as_uint(p0[9]), __float_as_uint(p0[10]), __float_as_uint(p0[11])}, w3_ = {__float_as_uint(p0[12]), __float_as_uint(p0[13]), __float_as_uint(p0[14]), __float_as_uint(p0[15])};
            const bf16x8 pa0 = __builtin_bit_cast(bf16x8, w0_), pa1 = __builtin_bit_cast(bf16x8, w1_), pa2 = __builtin_bit_cast(bf16x8, w2_), pa3 = __builtin_bit_cast(bf16x8, w3_);
            pv_tile(o, vb, pa0, pa1, pa2, pa3);
        }
        actQ = false;
        if (t < nt) {
            const int k0 = ATT_TILE(t);
            if (MODE == 0) actQ = (k0 < qmax) && !__all(carryP > 1e30f);
            else if (MODE == 1) actQ = (k0 <= qmax);
            else actQ = true;
            if (actQ) {
                const int K_a = ldsb + (t & 1) * AK_BUF;
#pragma unroll
                for (int r = 0; r < 16; ++r) { p0[r] = (MODE == 0) ? 0.f : nb[r]; p1[r] = (MODE == 0) ? 0.f : nb[r]; }
                constexpr int NC = ND / 2;
                bf16x8 xa[2], xb[2], ya[2], yb[2];
#define ATT_QK_ISSUE(c_, A_, B_) do { _Pragma("unroll") for (int i_ = 0; i_ < 2; ++i_) { const int d0 = 2 * (c_) + i_; \
        const int off = koff[d0]; \
        if (d0 < 8) { A_[i_] = lds_rd128<0>(K_a + off); B_[i_] = lds_rd128<32 * 256>(K_a + off); } else { A_[i_] = lds_rd128<0>(K_a + off); B_[i_] = lds_rd128<32 * 128>(K_a + off); } } } while (0)
#define ATT_QK_STEP(c_, A_, B_) do { if ((c_) + 1 < NC) asm volatile("s_waitcnt lgkmcnt(4)" : "+v"(A_[0]), "+v"(B_[0]), "+v"(A_[1]), "+v"(B_[1]) :: "memory"); \
        else asm volatile("s_waitcnt lgkmcnt(0)" : "+v"(A_[0]), "+v"(B_[0]), "+v"(A_[1]), "+v"(B_[1]) :: "memory"); \
        __builtin_amdgcn_sched_barrier(0); \
        p0 = __builtin_amdgcn_mfma_f32_32x32x16_bf16(A_[0], qr[2 * (c_)], p0, 0, 0, 0); p1 = __builtin_amdgcn_mfma_f32_32x32x16_bf16(B_[0], qr[2 * (c_)], p1, 0, 0, 0); \
        p0 = __builtin_amdgcn_mfma_f32_32x32x16_bf16(A_[1], qr[2 * (c_) + 1], p0, 0, 0, 0); p1 = __builtin_amdgcn_mfma_f32_32x32x16_bf16(B_[1], qr[2 * (c_) + 1], p1, 0, 0, 0); \
        __builtin_amdgcn_sched_barrier(0); \
        if ((c_) + 2 < NC) ATT_QK_ISSUE((c_) + 2, A_, B_); } while (0)
                ATT_QK_ISSUE(0, xa, xb); ATT_QK_ISSUE(1, ya, yb);
                ATT_QK_STEP(0, xa, xb); ATT_QK_STEP(1, ya, yb); ATT_QK_STEP(2, xa, xb); ATT_QK_STEP(3, ya, yb);
                if constexpr (NC > 4) { ATT_QK_STEP(4, xa, xb); ATT_QK_STEP(5, ya, yb); }
#undef ATT_QK_ISSUE
#undef ATT_QK_STEP
            }
        }
        if (grp == 1) asm volatile("s_waitcnt vmcnt(0)" ::: "memory");
        ATT_BAR();
        if (grp == 1) { if (t + 2 < nt0) ATT_DMAK(t + 2); if (t + 1 < nt0) ATT_DMAV(t + 1); }
        else if (MODE == 0 && t >= 1) {
            unsigned fw[8];
#pragma unroll
            for (int w = 0; w < 8; ++w) fw[w] = lds_rd32u(fl_a + (((t - 1) & 1) * 8 + w) * 4);
            asm volatile("s_waitcnt lgkmcnt(0)" : "+v"(fw[0]), "+v"(fw[1]), "+v"(fw[2]), "+v"(fw[3]), "+v"(fw[4]), "+v"(fw[5]), "+v"(fw[6]), "+v"(fw[7]) :: "memory");
            unsigned alld = 1u;
#pragma unroll
            for (int w = 0; w < 8; ++w) alld &= fw[w];
            if (__builtin_amdgcn_readfirstlane(alld) && t < nt) nt = t;
        }
        if (t < nt) {
        if (actQ) {
            const int k0 = ATT_TILE(t);
            const bool need_mask = (MODE != 2) && (k0 + 63 >= a.q0 + a.wave * 32);
            const int lim = qpos - (k0 + 32 * hi) + (MODE == 1 ? 1 : 0);
            if (MODE == 0) {
#pragma unroll
                for (int r = 0; r < 16; ++r) { p0[r] = __builtin_amdgcn_exp2f(p0[r]); p1[r] = __builtin_amdgcn_exp2f(p1[r]); }
                add1_16(p0); add1_16(p1);
                if (need_mask) {
#pragma unroll
                    for (int r = 0; r < 16; ++r) { p0[r] = (r < lim) ? p0[r] : 1.0f; p1[r] = (r + 16 < lim) ? p1[r] : 1.0f; }
                }
                cumprod_hi(p1, p0); cumprod_lo(p1, p0);
                const float run1 = p1[0], run0 = p0[0];
                const float run = run1 * run0;
                const auto rr = __builtin_amdgcn_permlane32_swap(__float_as_uint(run), __float_as_uint(run), false, false);
                const float tlo = __uint_as_float(rr[0]), thi = __uint_as_float(rr[1]);
                const float seed1 = carryP * (hi ? 1.0f : thi), seed0 = seed1 * run1;
                float sprev = __builtin_amdgcn_rcpf(seed1);
#pragma unroll
                for (int r = 0; r < 16; ++r) p1[r] = __builtin_amdgcn_rcpf(p1[r] * seed1);
                diff16(p1, sprev);
#pragma unroll
                for (int r = 0; r < 16; ++r) p0[r] = __builtin_amdgcn_rcpf(p0[r] * seed0);
                diff16(p0, sprev);
                carryP *= tlo * thi;
            } else {
                if (need_mask) {
#pragma unroll
                    for (int r = 0; r < 16; ++r) { p0[r] = (r < lim) ? p0[r] : -1e30f; p1[r] = (r + 16 < lim) ? p1[r] : -1e30f; }
                }
                float pmax = p0[0];
#pragma unroll
                for (int r = 1; r < 16; ++r) pmax = fmaxf(pmax, p0[r]);
#pragma unroll
                for (int r = 0; r < 16; ++r) pmax = fmaxf(pmax, p1[r]);
                { const auto rr = __builtin_amdgcn_permlane32_swap(__float_as_uint(pmax), __float_as_uint(pmax), false, false);
                  pmax = fmaxf(__uint_as_float(rr[0]), __uint_as_float(rr[1])); }
                if (t == 0) {
#pragma unroll
                    for (int r = 0; r < 16; ++r) { p0[r] -= pmax; p1[r] -= pmax; nb[r] = -pmax; }
                } else if (!__all(pmax <= THRS)) {
                    const float dm = fmaxf(pmax, 0.f);
                    const float alpha = __builtin_amdgcn_exp2f(-dm);
                    l_reg *= alpha;
#pragma unroll
                    for (int d = 0; d < 4; ++d)
#pragma unroll
                        for (int r = 0; r < 16; ++r) o[d][r] *= alpha;
#pragma unroll
                    for (int r = 0; r < 16; ++r) { p0[r] -= dm; p1[r] -= dm; nb[r] -= dm; }
                }
#pragma unroll
                for (int r = 0; r < 16; ++r) { p0[r] = __builtin_amdgcn_exp2f(p0[r]); p1[r] = __builtin_amdgcn_exp2f(p1[r]); }
                float ps = sum16(p0) + sum16(p1);
                { const auto rr = __builtin_amdgcn_permlane32_swap(__float_as_uint(ps), __float_as_uint(ps), false, false);
                  ps = __uint_as_float(rr[0]) + __uint_as_float(rr[1]); }
                l_reg += ps;
            }
            { unsigned w_[16];
#pragma unroll
              for (int i = 0; i < 8; ++i) { w_[i] = cvt_pk_bf16(p0[2 * i], p0[2 * i + 1]); w_[8 + i] = cvt_pk_bf16(p1[2 * i], p1[2 * i + 1]); }
#pragma unroll
              for (int i = 0; i < 16; ++i) p0[i] = __uint_as_float(w_[i]); }
        }
            actP = actQ;
            if (MODE == 0) { const bool dn = __all(carryP > 1e30f); if (lane == 0) lds_wr32u(fl_a + ((t & 1) * 8 + wid) * 4, dn ? 1u : 0u); }
        }
        if (grp == 0) asm volatile("s_waitcnt vmcnt(0)" ::: "memory");
        ATT_BAR();
    }
    if (grp == 0) ATT_BAR();
    asm volatile("s_waitcnt vmcnt(0)" ::: "memory");
#undef ATT_TILE
#undef ATT_DMA
#undef ATT_DMAK
#undef ATT_DMAV
    int tz = MY_TID(a.wave); asm volatile("" : "+v"(tz));
    const int wid2 = tz >> 6, r32b = tz & 31, hib = (tz >> 5) & 1;
    const float rl = (MODE != 0) ? __builtin_amdgcn_rcpf(l_reg) : 1.0f;
    bf16_t* Ow = a.O + (size_t)(wid2 * 32 + r32b) * a.ldo + 8 * hib;
#pragma unroll
    for (int d0 = 0; d0 < 4; ++d0)
#pragma unroll
        for (int k = 0; k < 2; ++k) {
            unsigned ax = cvt_pk_bf16(o[d0][8 * k + 0] * rl, o[d0][8 * k + 1] * rl), ay = cvt_pk_bf16(o[d0][8 * k + 2] * rl, o[d0][8 * k + 3] * rl);
            unsigned bx = cvt_pk_bf16(o[d0][8 * k + 4] * rl, o[d0][8 * k + 5] * rl), by = cvt_pk_bf16(o[d0][8 * k + 6] * rl, o[d0][8 * k + 7] * rl);
            const auto rx = __builtin_amdgcn_permlane32_swap(ax, bx, false, false); const auto ry = __builtin_amdgcn_permlane32_swap(ay, by, false, false);
            const u32x4 w = {rx[0], ry[0], rx[1], ry[1]};
            *(u32x4*)(Ow + d0 * 32 + 16 * k) = w;
        }
}
}

#define XB_TMO      128
#define XB_XCNT(j)  (256  + 64 * (j))
#define XB_XSUB(j)  (1280 + 64 * (j))
#define XB_XGEN(j)  (2304 + 64 * (j))
#define XB_TOP      3328
#define XB_TOPGEN   3392
#define XCD_BAR_WORDS 3456
#define XB_SPIN_CAP (1u << 22)
__device__ __forceinline__ unsigned xb_ld(unsigned* p)              { return __hip_atomic_load(p, __ATOMIC_RELAXED, __HIP_MEMORY_SCOPE_AGENT); }
__device__ __forceinline__ unsigned xb_add(unsigned* p, unsigned v) { return __hip_atomic_fetch_add(p, v, __ATOMIC_RELAXED, __HIP_MEMORY_SCOPE_AGENT); }
__device__ __forceinline__ unsigned xb_xcc_id() { return (unsigned)__builtin_amdgcn_s_getreg((3 << 11) | 20) & 0xFu; }
#define XB_SPIN(cond, bar) do { unsigned _sp = 0; while (cond) { __builtin_amdgcn_s_sleep(1); \
    if ((++_sp & 255u) == 0u) { if (xb_ld(&(bar)[XB_TMO])) break; if (_sp > XB_SPIN_CAP) { atomicAdd(&(bar)[XB_TMO], 1u); break; } } } } while (0)
struct XcdBarrier { unsigned* bar; unsigned x; volatile LAS unsigned* st; int wave; };
__device__ __forceinline__ XcdBarrier xcd_barrier_post(unsigned* bar, volatile LAS unsigned* st, int wave) {
    XcdBarrier b; b.bar = bar; b.x = xb_xcc_id(); b.st = st; b.wave = wave;
    if (MY_TID(wave) == 0) (void)xb_add(&bar[XB_XCNT(b.x)], 1u);
    return b;
}
__device__ __forceinline__ void xcd_barrier_complete(unsigned* bar, unsigned x, unsigned& nloc, unsigned& nx) {
    const unsigned G = gridDim.x * gridDim.y * gridDim.z;
    unsigned sum, cnt, mine, sp = 0u;
    for (;;) {
        sum = 0u; cnt = 0u; mine = 0u;
#pragma unroll
        for (unsigned j = 0; j < 16; ++j) { const unsigned c = xb_ld(&bar[XB_XCNT(j)]); sum += c; cnt += (c > 0u) ? 1u : 0u; mine = (j == x) ? c : mine; }
        if (sum == G) break;
        __builtin_amdgcn_s_sleep(1);
        if ((++sp & 255u) == 0u) { if (xb_ld(&bar[XB_TMO])) break; if (sp > XB_SPIN_CAP) { atomicAdd(&bar[XB_TMO], 1u); break; } }
    }
    nloc = mine > 0u ? mine : 1u; nx = cnt > 0u ? cnt : 1u;
}
__device__ __forceinline__ void xcd_barrier(const XcdBarrier& b) {
    asm volatile("s_waitcnt vmcnt(0)" ::: "memory");
    __syncthreads();
    if (MY_TID(b.wave) == 0) {
        unsigned* bar = b.bar;
        __builtin_amdgcn_s_waitcnt(0);
        unsigned nloc = b.st[0], nx = b.st[1];
        if (nloc == 0u) { xcd_barrier_complete(bar, b.x, nloc, nx); b.st[0] = nloc; b.st[1] = nx; }
        const unsigned old = xb_add(&bar[XB_XSUB(b.x)], 1u);
        const unsigned gen = old / nloc;
        if (old + 1u == (gen + 1u) * nloc) {
            __builtin_amdgcn_fence(__ATOMIC_RELEASE, "agent");
            asm volatile("s_waitcnt vmcnt(0)" ::: "memory");
            const unsigned og = xb_add(&bar[XB_TOP], 1u);
            const unsigned tg = og / nx;
            if (og + 1u == (tg + 1u) * nx) xb_add(&bar[XB_TOPGEN], 1u);
            else XB_SPIN(xb_ld(&bar[XB_TOPGEN]) == tg, bar);
            __builtin_amdgcn_fence(__ATOMIC_ACQUIRE, "agent");
            xb_add(&bar[XB_XGEN(b.x)], 1u);
            asm volatile("s_waitcnt vmcnt(0)" ::: "memory");
        } else {
            XB_SPIN(xb_ld(&bar[XB_XGEN(b.x)]) == gen, bar);
            __builtin_amdgcn_fence(__ATOMIC_ACQUIRE, "agent");
            asm volatile("s_waitcnt vmcnt(0)" ::: "memory");
        }
    }
    __syncthreads();
}

enum { MAP_ID = 0, MAP_GU = 1, MAP_DKV = 2, MAP_UQ = 3 };
struct CvtJob { int in_idx; int ldw; int K; int gain_idx; int gain_off; int dst_row0; int nrows; int map; long src_off; long dst_off; };
constexpr int NJOBS = 24;
__device__ const CvtJob JOBS[NJOBS] = {
    {5, 5120, 2048, 3, 0, 0, 5120, MAP_ID, 0L, (long)W_AIN},
    {5, 5120, 2048, 3, 2048, 0, 5120, MAP_ID, 2048L * 5120, (long)(W_AIN + (size_t)5120 * 2048 * 2)},
    {6, 2048, 2048, -1, 0, 0, 2048, MAP_ID, 0L, (long)W_AOUT},
    {6, 2048, 2048, -1, 0, 0, 2048, MAP_ID, 2048L * 2048, (long)(W_AOUT + (size_t)2048 * 2048 * 2)},
    {7, 1024, 2048, 3, 4096, 0, 1024, MAP_ID, 0L, (long)W_BIN},
    {7, 1024, 2048, 3, 6144, 0, 1024, MAP_ID, 2048L * 1024, (long)(W_BIN + (size_t)1792 * 2048 * 2)},
    {14, 576, 2048, 13, 0, 1024, 768, MAP_DKV, 0L, (long)W_BIN},
    {9, 2304, 512, 8, 0, 0, 2304, MAP_UQ, 0L, (long)W_UQ},
    {9, 2304, 512, 8, 512, 0, 2304, MAP_UQ, 512L * 2304, (long)(W_UQ + (size_t)2304 * 512 * 2)},
    {10, 2048, 2048, -1, 0, 0, 2048, MAP_ID, 0L, (long)W_BOUT},
    {10, 2048, 2048, -1, 0, 0, 2048, MAP_ID, 2048L * 2048, (long)(W_BOUT + (size_t)2048 * 2048 * 2)},
    {12, 1024, 2048, -1, 0, 0, 1024, MAP_ID, 0L, (long)W_MEMKV},
    {12, 1024, 2048, -1, 0, 1024, 1024, MAP_ID, 2048L * 1024, (long)W_MEMKV},
    {12, 1024, 2048, -1, 0, 2048, 1024, MAP_ID, 2L * 2048 * 1024, (long)W_MEMKV},
    {12, 1024, 2048, -1, 0, 3072, 1024, MAP_ID, 3L * 2048 * 1024, (long)W_MEMKV},
    {16, 3072, 512, 15, 0, 0, 3072, MAP_ID, 0L, (long)W_UKV},
    {17, 11264, 2048, 4, 0, 0, 11264, MAP_GU, 0L, (long)W_GU},
    {17, 11264, 2048, 4, 2048, 0, 11264, MAP_GU, 2048L * 11264, (long)(W_GU + (size_t)11264 * 2048 * 2)},
    {17, 11264, 2048, 4, 4096, 0, 11264, MAP_GU, 2L * 2048 * 11264, (long)(W_GU + (size_t)2 * 11264 * 2048 * 2)},
    {17, 11264, 2048, 4, 6144, 0, 11264, MAP_GU, 3L * 2048 * 11264, (long)(W_GU + (size_t)3 * 11264 * 2048 * 2)},
    {18, 2048, 5632, -1, 0, 0, 2048, MAP_ID, 0L, (long)W_DN},
    {18, 2048, 5632, -1, 0, 0, 2048, MAP_ID, 5632L * 2048, (long)(W_DN + (size_t)2048 * 5632 * 2)},
    {18, 2048, 5632, -1, 0, 0, 2048, MAP_ID, 2L * 5632 * 2048, (long)(W_DN + (size_t)2 * 2048 * 5632 * 2)},
    {18, 2048, 5632, -1, 0, 0, 2048, MAP_ID, 3L * 5632 * 2048, (long)(W_DN + (size_t)3 * 2048 * 5632 * 2)},
};
__device__ __forceinline__ int ropeperm(int p) { const int t = p >> 3, e = p & 7; return (e < 4) ? 4 * t + e : 32 + 4 * t + (e - 4); }
__device__ __forceinline__ int map_col(int map, int nr) {
    if (map == MAP_ID) return nr;
    if (map == MAP_GU) { const int tile = nr >> 8, j = nr & 255; return (j < 128) ? 128 * tile + j : FFN + 128 * tile + (j - 128); }
    if (map == MAP_DKV) { return (nr < 512) ? nr : ((nr < 576) ? 512 + ropeperm(nr - 512) : -1); }
    const int head = nr / 192, o = nr - head * 192; return (o < 128) ? nr : head * 192 + 128 + ropeperm(o - 128);
}

struct KArgs { const void* in[20]; float* out; unsigned char* ws; int ph_lo, ph_hi; };

__device__ __forceinline__ void cvt_load(const KArgs& A, const CvtJob& J, int item, int lane, f32x4 (&v)[8]) {
    const int nblk = J.nrows / 32, kb = item / nblk, nb = item - kb * nblk, k0 = 64 * kb, n0 = 32 * nb;
    const float* W = (const float*)A.in[J.in_idx] + J.src_off;
    const int col = map_col(J.map, n0 + 4 * (lane & 7));
    const float* wp = W + (size_t)(k0 + (lane >> 3)) * J.ldw + (col >= 0 ? col : 0);
#pragma unroll
    for (int i = 0; i < 8; ++i) v[i] = __builtin_nontemporal_load((const f32x4*)(wp + (size_t)(8 * i) * J.ldw));
}
__device__ __forceinline__ void cvt_store(const KArgs& A, const CvtJob& J, int item, LAS float* scr, int lane, const f32x4 (&v)[8]) {
    const int nblk = J.nrows / 32, kb = item / nblk, nb = item - kb * nblk, k0 = 64 * kb, n0 = 32 * nb;
    const int col = map_col(J.map, n0 + 4 * (lane & 7));
    const int c = lane & 7;
    f32x4 g0 = (f32x4){1.f, 1.f, 1.f, 1.f}, g1 = g0;
    if (J.gain_idx >= 0) { const float* gain = (const float*)A.in[J.gain_idx] + J.gain_off + k0 + 8 * c; g0 = *(const f32x4*)gain; g1 = *(const f32x4*)(gain + 4); }
#pragma unroll
    for (int i = 0; i < 8; ++i)
#pragma unroll
        for (int e = 0; e < 4; ++e) scr[(8 * i + (lane >> 3)) * 33 + 4 * c + e] = (col >= 0) ? v[i][e] : 0.f;
    asm volatile("s_waitcnt lgkmcnt(0)" ::: "memory");
    bf16_t* dst = (bf16_t*)(A.ws + J.dst_off);
#pragma unroll
    for (int j = 0; j < 4; ++j) { const int n = (lane >> 3) + 8 * j; const LAS float* s = scr + (8 * c) * 33 + n;
        u32x4 o; o.x = pk2(s[0 * 33] * g0[0], s[1 * 33] * g0[1]); o.y = pk2(s[2 * 33] * g0[2], s[3 * 33] * g0[3]); o.z = pk2(s[4 * 33] * g1[0], s[5 * 33] * g1[1]); o.w = pk2(s[6 * 33] * g1[2], s[7 * 33] * g1[3]);
        *(u32x4*)(dst + (size_t)(J.dst_row0 + n0 + n) * J.K + k0 + 8 * c) = o; }
    asm volatile("s_waitcnt lgkmcnt(0)" ::: "memory");
}
__device__ __forceinline__ bool cvt_locate(int g, int& jb, int& local) {
    int b = 0;
    for (jb = 0; jb < NJOBS; ++jb) { const int n = (JOBS[jb].nrows / 32) * (JOBS[jb].K / 64); if (g < b + n) { local = g - b; return true; } b += n; }
    return false;
}

struct Ctx { LAS unsigned char* lds; unsigned char* ws; float* out; const float* x; int G, bx, vcu, lo, hi, wave; XcdBarrier bar; };
#define IN(k) (lo <= (k) && (k) < hi)
#define SEAM(k) do { if ((k) + 1 < hi) xcd_barrier(bar); } while (0)
template <int L>
__device__ __forceinline__ void layer_phases(const Ctx& c) {
    LAS unsigned char* lds = c.lds; unsigned char* ws = c.ws; float* out = c.out; const float* x = c.x;
    const int G = c.G, bx = c.bx, vcu = c.vcu, lo = c.lo, hi = c.hi, wave = c.wave; const XcdBarrier bar = c.bar;
    float* SS = (float*)(ws + WS_SS); float* SSQ = (float*)(ws + WS_SSQ); float* SSL = (float*)(ws + WS_SSL);
    float* COS = (float*)(ws + WS_COS); float* SIN = (float*)(ws + WS_SIN);
    bf16_t* HB = (bf16_t*)(ws + WS_HB); bf16_t* KV = (bf16_t*)(ws + WS_KV); bf16_t* KR = (bf16_t*)(ws + WS_KR);
    bf16_t* MEMKV = (bf16_t*)(ws + WS_MEMKV); bf16_t* MEMN = (bf16_t*)(ws + WS_MEMN);
    bf16_t* PROJ = (bf16_t*)(ws + WS_PROJ); bf16_t* PB = (bf16_t*)(ws + WS_PB); bf16_t* QB = (bf16_t*)(ws + WS_Q);
    bf16_t* MIX = (bf16_t*)(ws + WS_MIX); bf16_t* HID = (bf16_t*)(ws + WS_HID);
    {
        constexpr int pb = 1 + 6 * L; constexpr bool isA = L < 2; constexpr int li = L & 1;
        if (IN(pb)) {
            if (L == 0) {
                pg8::Gemm g{MEMN, (const bf16_t*)(ws + W_MEMKV), MROWS, 4096, 2048, 2048, 2048}; pg8::StaticOrder S; S.init(MROWS, 4096, G, bx);
                EpiScaleBf16<0> E{MEMKV, 4096, nullptr};
                pg8::gemm_phase(lds, g, S, E, wave);
            }
            if (isA) {
                pg8::Gemm g{HB, (const bf16_t*)(ws + W_AIN) + (size_t)li * 5120 * 2048, M, A_IN, 2048, 2048, 2048}; pg8::StaticOrder S; S.init(M, A_IN, G, bx);
                EpiScaleBf16<1> E{PROJ, A_IN, SS};
                if (PROBE_NULL_AIN) { EpiNull E0{SSQ}; pg8::gemm_phase(lds, g, S, E0, wave); }
                pg8::gemm_phase(lds, g, S, E, wave);
            } else {
                const int N = (L == 2) ? 1792 : 1024;
                pg8::Gemm g{HB, (const bf16_t*)(ws + W_BIN) + (size_t)li * 1792 * 2048, M, N, 2048, 2048, 2048}; pg8::StaticOrder S; S.init(M, N, G, bx);
                EpiBIn E{PB, KR, SS, SSQ, SSL, COS, SIN};
                pg8::gemm_phase(lds, g, S, E, wave);
            }
            SEAM(pb);
        }
        if (!isA && IN(pb + 1)) {
            { pg8::Gemm g{PB, (const bf16_t*)(ws + W_UQ) + (size_t)li * 2304 * 512, M, UQ_N, 512, PB_LD, 512}; pg8::StaticOrder S; S.init(M, UQ_N, G, bx);
              EpiUq E{QB, SSQ, COS, SIN};
              pg8::gemm_phase(lds, g, S, E, wave); }
            if (L == 2) {
                pg8::Gemm g{PB + 1024, (const bf16_t*)(ws + W_UKV), M, UKV_N, 512, PB_LD, 512}; pg8::StaticOrder S; S.init(M, UKV_N, G, bx);
                EpiScaleBf16<2> E{KV, KVLD, SSL};
                pg8::gemm_phase(lds, g, S, E, wave);
            }
            SEAM(pb + 1);
        }
        if (IN(pb + 2)) {
          for (int rep = 0; rep < PROBE_ATT; ++rep) {
            for (int rep2 = 0; rep2 < PROBE_ATT_MAIN; ++rep2)
            for (int p = vcu; p < BATCH * NH * 4; p += G) {
                const int xx = p & 3, bh = p >> 2, b = bh / NH, h = bh - b * NH;
                for (int half = 0; half < 2; ++half) {
                    const int xq = half ? (7 - xx) : xx;
                    const size_t tok0 = (size_t)b * SEQ, tq = tok0 + (size_t)xq * 256;
                    if (isA) {
                        att::Args a{PROJ + tq * A_IN + h * 128, A_IN, PROJ + tok0 * A_IN + 1536 + h * 128, A_IN, nullptr, 0,
                                    PROJ + tok0 * A_IN + 3072 + h * 128, A_IN, MIX + tq * DM + h * 128, DM, xq * 256, 4 * (xq + 1), wave};
                        att::attn_unit<0, 128>(lds, a);
                    } else {
                        att::Args a{QB + tq * UQ_N + h * 192, UQ_N, KV + tok0 * KVLD + h * 256, KVLD, KR + tok0 * 64, 64,
                                    KV + tok0 * KVLD + h * 256 + 128, KVLD, MIX + tq * DM + h * 128, DM, xq * 256, 4 * (xq + 1), wave};
                        att::attn_unit<1, 192>(lds, a);
                    }
                }
            }
            for (int rep2 = 0; rep2 < PROBE_ATT_MEM; ++rep2)
            for (int p = vcu; p < BATCH * MEMH * 8; p += G) {
                const int xq = p & 7, bh = p >> 3, b = bh >> 2, h = bh & 3;
                const size_t tq = (size_t)b * SEQ + (size_t)xq * 256;
                const bf16_t* Qp = isA ? (PROJ + tq * A_IN + 4608 + h * 128) : (PB + tq * PB_LD + 512 + h * 128);
                const bf16_t* Kp = MEMKV + (size_t)(b * MEML) * 4096 + L * 1024 + h * 128;
                att::Args a{Qp, isA ? A_IN : PB_LD, Kp, 4096, nullptr, 0, Kp + 512, 4096, MIX + tq * DM + 1536 + h * 128, DM, 0, 4, wave};
                att::attn_unit<2, 128>(lds, a);
            }
            __syncthreads();
          }
            SEAM(pb + 2);
        }
        if (IN(pb + 3)) {
            const bf16_t* Wt = (const bf16_t*)(ws + (isA ? W_AOUT : W_BOUT)) + (size_t)li * 2048 * 2048;
            pg8::Gemm g{MIX, Wt, M, DM, 2048, 2048, 2048}; pg8::StaticOrder S; S.init(M, DM, G, bx);
            if (PROBE_NULL_OUT) { EpiNull E0{SSQ}; pg8::gemm_phase(lds, g, S, E0, wave); }
            EpiResid<false, false> E{x, out, HB, SS, (LAS float*)(lds + LDSCTL_OFF + 2048)};
            pg8::gemm_phase(lds, g, S, E, wave);
            SEAM(pb + 3);
        }
        if (IN(pb + 4)) {
            pg8::Gemm g{HB, (const bf16_t*)(ws + W_GU) + (size_t)L * 11264 * 2048, M, 2 * FFN, 2048, 2048, 2048}; pg8::StaticOrder S; S.init(M, 2 * FFN, G, bx);
#if PROBE_SPLIT_GU
            { pg8::Gemm g1 = g; g1.N = FFN; pg8::StaticOrder S1; S1.init(M, FFN, G, bx); EpiSwiglu E1{HID, SS, 0};
              pg8::gemm_phase(lds, g1, S1, E1, wave);
              xcd_barrier(bar);
              pg8::Gemm g2 = g1; g2.Bt = g.Bt + (size_t)FFN * 2048; EpiSwiglu E2{HID, SS, FFN / 2};
              pg8::gemm_phase(lds, g2, S1, E2, wave); }
#else
            EpiSwiglu E{HID, SS, 0};
            pg8::gemm_phase(lds, g, S, E, wave);
            if (PROBE_GU > 1) pg8::gemm_phase(lds, g, S, E, wave);
#endif
            SEAM(pb + 4);
        }
        if (IN(pb + 5)) {
            pg8::Gemm g{HID, (const bf16_t*)(ws + W_DN) + (size_t)L * 2048 * 5632, M, DM, FFN, FFN, FFN}; pg8::StaticOrder S; S.init(M, DM, G, bx);
            if (PROBE_NULL_DN) { EpiNull E0{SSQ}; pg8::gemm_phase(lds, g, S, E0, wave); }
            EpiResid<false, false> E{x, out, HB, SS, (LAS float*)(lds + LDSCTL_OFF + 2048)};
            pg8::gemm_phase(lds, g, S, E, wave);
            SEAM(pb + 5);
        }
    }
}
#undef IN
#undef SEAM
__global__ void __launch_bounds__(512, 2) yoco_fwd(KArgs args) {
    extern __shared__ __attribute__((aligned(16))) unsigned char lds_raw[];
    LAS unsigned char* lds = (LAS unsigned char*)lds_raw;
    volatile LAS unsigned* MISC = (volatile LAS unsigned*)(lds + MISC_OFF);
    const int wave = __builtin_amdgcn_readfirstlane((int)threadIdx.x >> 6);
    const int tid = MY_TID(wave), lane = tid & 63;
    const int G = gridDim.x, bx = blockIdx.x;
    const int vcu = (G % 8 == 0) ? (bx % 8) * (G / 8) + bx / 8 : bx;
    unsigned char* ws = args.ws;
    unsigned* ctl = (unsigned*)(ws + WS_CTL);
    for (int u = tid; u < (LDS_BYTES - LDSCTL_OFF) / 4; u += 512) ((LAS unsigned*)(lds + LDSCTL_OFF))[u] = 0u;
    __syncthreads();
    const int lo = args.ph_lo, hi = args.ph_hi;
    XcdBarrier bar; bar.bar = ctl + CW_BAR; bar.x = 0; bar.st = MISC + 8; bar.wave = wave;
    if (hi - lo > 1) bar = xcd_barrier_post(ctl + CW_BAR, MISC + 8, wave);
#define IN(k) (lo <= (k) && (k) < hi)
#define SEAM(k) do { if ((k) + 1 < hi) xcd_barrier(bar); } while (0)

    const float* x = (const float*)args.in[0];
    float* out = args.out;
    float* SS = (float*)(ws + WS_SS); float* SSQ = (float*)(ws + WS_SSQ); float* SSL = (float*)(ws + WS_SSL);
    float* COS = (float*)(ws + WS_COS); float* SIN = (float*)(ws + WS_SIN);
    bf16_t* HB = (bf16_t*)(ws + WS_HB); bf16_t* KV = (bf16_t*)(ws + WS_KV); bf16_t* KR = (bf16_t*)(ws + WS_KR);
    bf16_t* MEMKV = (bf16_t*)(ws + WS_MEMKV); bf16_t* MEMN = (bf16_t*)(ws + WS_MEMN);
    bf16_t* PROJ = (bf16_t*)(ws + WS_PROJ); bf16_t* PB = (bf16_t*)(ws + WS_PB); bf16_t* QB = (bf16_t*)(ws + WS_Q);
    bf16_t* MIX = (bf16_t*)(ws + WS_MIX); bf16_t* HID = (bf16_t*)(ws + WS_HID);
    const int gw = vcu * 8 + wave, NGW = G * 8;

    if (IN(0)) {
      for (int rep = 0; rep < PROBE_PRO; ++rep) {
        LAS float* scr = (LAS float*)(lds + wave * 16384);
        { f32x4 va[8], vb[8]; int ja = 0, la = 0, jbn = 0, lb = 0;
          int gi = gw; bool ha = cvt_locate(gi, ja, la);
          if (ha) cvt_load(args, JOBS[ja], la, lane, va);
          while (ha) {
              const bool hb = cvt_locate(gi + NGW, jbn, lb);
              if (hb) cvt_load(args, JOBS[jbn], lb, lane, vb);
              cvt_store(args, JOBS[ja], la, scr, lane, va);
              if (!hb) break;
              gi += 2 * NGW; ha = cvt_locate(gi, ja, la);
              if (ha) cvt_load(args, JOBS[ja], la, lane, va);
              cvt_store(args, JOBS[jbn], lb, scr, lane, vb);
          } }
        { f32x4 va[8], vb[8];
          auto ldrow = [&](f32x4 (&v)[8], int m) { const f32x4* xr = (const f32x4*)(x + (size_t)m * DM) + lane;
#pragma unroll
              for (int j = 0; j < 8; ++j) v[j] = __builtin_nontemporal_load(xr + 64 * j); };
          auto strow = [&](const f32x4 (&v)[8], int m) { float s = 0.f;
#pragma unroll
              for (int j = 0; j < 8; ++j) s += sq4(v[j]);
              s = wave_sum(s);
              u32x2* o8 = (u32x2*)(HB + (size_t)m * DM) + lane;
#pragma unroll
              for (int j = 0; j < 8; ++j) { u32x2 w; w.x = pk2(v[j][0], v[j][1]); w.y = pk2(v[j][2], v[j][3]); o8[64 * j] = w; }
              if (lane < 8) SS[(size_t)m * 8 + lane] = (lane == 0) ? s : 0.f; };
          int m = gw; if (m < M) ldrow(va, m);
          while (m < M) {
              const int mn = m + NGW; if (mn < M) ldrow(vb, mn);
              strow(va, m);
              if (mn >= M) break;
              m = mn + NGW; if (m < M) ldrow(va, m);
              strow(vb, mn);
          } }
        { const float* mem = (const float*)args.in[1]; const float* mg = (const float*)args.in[11];
          for (int m = gw; m < MROWS; m += NGW) {
            const f32x4* xr = (const f32x4*)(mem + (size_t)m * DM) + lane; const f32x4* gr = (const f32x4*)mg + lane;
            f32x4 v[8]; float s = 0.f;
#pragma unroll
            for (int j = 0; j < 8; ++j) { v[j] = __builtin_nontemporal_load(xr + 64 * j); s += sq4(v[j]); }
            s = wave_sum(s); const float rstd = rsq(s * (1.0f / 2048.0f) + RMS_EPS);
            u32x2* o8 = (u32x2*)(MEMN + (size_t)m * DM) + lane;
#pragma unroll
            for (int j = 0; j < 8; ++j) { const f32x4 gg = gr[64 * j]; const f32x4 y = v[j] * rstd * gg; u32x2 w; w.x = pk2(y[0], y[1]); w.y = pk2(y[2], y[3]); o8[64 * j] = w; }
          } }
        { const int* pos = (const int*)args.in[2];
          for (int idx = (vcu * 512 + tid); idx < M * 32; idx += G * 512) {
            const int tok = idx >> 5, i = idx & 31;
            const float inv_freq = __builtin_amdgcn_exp2f((float)i * (-13.287712379549449f / 32.0f));
            const float ang = (float)pos[tok] * inv_freq;
            const double rev = (double)ang * 0.15915494309189535;
            const float fr_ = (float)(rev - floor(rev));
            COS[idx] = __builtin_amdgcn_cosf(fr_); SIN[idx] = __builtin_amdgcn_sinf(fr_);
          } }
      }
        SEAM(0);
    }

    { Ctx c{lds, ws, out, x, G, bx, vcu, lo, hi, wave, bar};
      layer_phases<0>(c); layer_phases<1>(c); layer_phases<2>(c); layer_phases<3>(c); }
    if (IN(25)) {
        const float* fg = (const float*)args.in[19];
        int tz = MY_TID(wave); asm volatile("" : "+v"(tz));
        const int lane = tz & 63, gw = vcu * 8 + (tz >> 6);
        { u32x2 wa[8], wb[8]; float sa = 0.f, sb = 0.f;
          auto ldrow = [&](u32x2 (&w)[8], float& s, int m) { s = (lane < 8) ? SS[(size_t)m * 8 + lane] : 0.f;
              const u32x2* hr = (const u32x2*)((const bf16_t*)(ws + WS_HB) + (size_t)m * DM) + lane;
#pragma unroll
              for (int j = 0; j < 8; ++j) w[j] = hr[64 * j]; };
          auto strow = [&](const u32x2 (&w)[8], float s, int m) { s = wave_sum(s); const float rstd = rsq(s * (1.0f / 2048.0f) + RMS_EPS);
              f32x4* xr = (f32x4*)(out + (size_t)m * DM) + lane; const f32x4* gr = (const f32x4*)fg + lane;
#pragma unroll
              for (int j = 0; j < 8; ++j) { const f32x4 v = (f32x4){__uint_as_float(w[j].x << 16), __uint_as_float(w[j].x & 0xffff0000u), __uint_as_float(w[j].y << 16), __uint_as_float(w[j].y & 0xffff0000u)};
                  __builtin_nontemporal_store(v * rstd * gr[64 * j], xr + 64 * j); } };
          int m = gw; if (m < M) ldrow(wa, sa, m);
          while (m < M) {
              const int mn = m + NGW; if (mn < M) ldrow(wb, sb, mn);
              strow(wa, sa, m);
              if (mn >= M) break;
              m = mn + NGW; if (m < M) ldrow(wa, sa, m);
              strow(wb, sb, mn);
          } }
    }
#undef IN
#undef SEAM
}

extern "C" void kernel_launch(void* const* d_in, const int* in_sizes, int n_in, void* d_out, int out_size, void* d_ws, size_t ws_size, hipStream_t stream) {
    static int grid = 0;
    if (grid == 0) {
        if (n_in != 20 || out_size != M * DM || ws_size < WS_END) { fprintf(stderr, "kernel_launch: unexpected shapes (n_in %d out %d ws %zu need %zu)\n", n_in, out_size, ws_size, (size_t)WS_END); grid = -1; return; }
        int dev = 0, cus = 0, per_cu = 0;
        if (hipGetDevice(&dev) != hipSuccess || hipDeviceGetAttribute(&cus, hipDeviceAttributeMultiprocessorCount, dev) != hipSuccess) { grid = -1; return; }
        if (hipFuncSetAttribute((const void*)yoco_fwd, hipFuncAttributeMaxDynamicSharedMemorySize, LDS_BYTES) != hipSuccess) { fprintf(stderr, "kernel_launch: hipFuncSetAttribute failed\n"); grid = -1; return; }
        if (hipOccupancyMaxActiveBlocksPerMultiprocessor(&per_cu, (const void*)yoco_fwd, 512, LDS_BYTES) != hipSuccess || per_cu < 1) { fprintf(stderr, "kernel_launch: occupancy query says %d\n", per_cu); (void)hipGetLastError(); }
        grid = cus;
    }
    if (grid < 0) return;
    (void)hipMemsetAsync((char*)d_ws + WS_CTL, 0, CTL_ZERO_BYTES, stream);
    KArgs a{};
    for (int i = 0; i < 20; ++i) a.in[i] = d_in[i];
    a.out = (float*)d_out; a.ws = (unsigned char*)d_ws;
#if MK_PER_PHASE
    for (int k = 0; k < 26; ++k) {
        if (k >= 1 && k <= 12 && ((k - 1) % 6) == 1) continue;
        a.ph_lo = k; a.ph_hi = k + 1;
        hipLaunchKernelGGL(yoco_fwd, dim3(grid), dim3(512), LDS_BYTES, stream, a);
    }
#else
    a.ph_lo = 0; a.ph_hi = 26;
    hipLaunchKernelGGL(yoco_fwd, dim3(grid), dim3(512), LDS_BYTES, stream, a);
#endif
    const hipError_t le = hipPeekAtLastError();
    if (le != hipSuccess) fprintf(stderr, "kernel_launch: launch failed: %s\n", hipGetErrorName(le));
}
```

```cpp
#include <hip/hip_runtime.h>
#include <cstdio>
#include <cstdint>

#ifndef MK_PER_PHASE
#define MK_PER_PHASE 0
#endif

#ifndef PROBE_ATT
#define PROBE_ATT 1
#endif
#ifndef PROBE_ATT_MAIN
#define PROBE_ATT_MAIN 1
#endif
#ifndef PROBE_ATT_MEM
#define PROBE_ATT_MEM 1
#endif
#ifndef PROBE_GU
#define PROBE_GU 1
#endif
#ifndef PROBE_PRO
#define PROBE_PRO 1
#endif
#ifndef PROBE_EPI
#define PROBE_EPI 1
#endif
#ifndef PROBE_NULL_DN
#define PROBE_NULL_DN 0
#endif
#ifndef PROBE_NULL_OUT
#define PROBE_NULL_OUT 0
#endif
#ifndef PROBE_NULL_AIN
#define PROBE_NULL_AIN 0
#endif
#ifndef PROBE_NULL_B
#define PROBE_NULL_B 0
#endif
#ifndef PROBE_EPI_WHICH
#define PROBE_EPI_WHICH 0
#endif
#ifndef PROBE_SPLIT_GU
#define PROBE_SPLIT_GU 0
#endif
#define LAS __attribute__((address_space(3)))
#define GAS __attribute__((address_space(1)))
typedef unsigned short bf16_t;
typedef short bf16x8 __attribute__((ext_vector_type(8)));
typedef short s16x4 __attribute__((ext_vector_type(4)));
typedef float f32x4 __attribute__((ext_vector_type(4)));
typedef float f32x16 __attribute__((ext_vector_type(16)));
typedef unsigned u32x4 __attribute__((ext_vector_type(4)));
typedef unsigned u32x2 __attribute__((ext_vector_type(2)));

constexpr int BATCH = 16, SEQ = 2048, DM = 2048, M = BATCH * SEQ;
constexpr int NH = 12, HD = 128, MEMH = 4, MEML = 256, MROWS = BATCH * MEML;
constexpr int FFN = 5632;
constexpr int A_IN = 5120, PB_LD = 1792, UQ_N = 2304, UKV_N = 3072, KVLD = 3072;
constexpr float RMS_EPS = 1e-6f;

constexpr size_t MiB = 1u << 20;
constexpr size_t WS_CTL = 0, CTL_ZERO_BYTES = 64 * 1024;
constexpr size_t WS_SS = 1 * MiB;
constexpr size_t WS_SSQ = 5 * MiB;
constexpr size_t WS_SSL = 6 * MiB;
constexpr size_t WS_COS = 7 * MiB;
constexpr size_t WS_SIN = 11 * MiB;
constexpr size_t WS_HB = 16 * MiB;
constexpr size_t WS_KV = 144 * MiB;
constexpr size_t WS_KR = 336 * MiB;
constexpr size_t WS_MEMKV = 340 * MiB;
constexpr size_t WS_MEMN = 372 * MiB;
constexpr size_t WS_BIG = 388 * MiB;
constexpr size_t WS_PROJ = WS_BIG;
constexpr size_t WS_PB = WS_BIG;
constexpr size_t WS_Q = WS_BIG + 112 * MiB;
constexpr size_t WS_MIX = WS_BIG + 320 * MiB;
constexpr size_t WS_HID = WS_BIG;
constexpr size_t WS_W = 836 * MiB;
constexpr size_t W_AIN = WS_W;
constexpr size_t W_AOUT = W_AIN + 40 * MiB;
constexpr size_t W_BIN = W_AOUT + 16 * MiB;
constexpr size_t W_UQ = W_BIN + 14 * MiB;
constexpr size_t W_BOUT = W_UQ + 5 * MiB;
constexpr size_t W_MEMKV = W_BOUT + 16 * MiB;
constexpr size_t W_UKV = W_MEMKV + 16 * MiB;
constexpr size_t W_GU = W_UKV + 3 * MiB;
constexpr size_t W_DN = W_GU + 176 * MiB;
constexpr size_t WS_END = W_DN + 88 * MiB;
static_assert(WS_HID + (size_t)M * FFN * 2 <= WS_W && WS_MIX + (size_t)M * DM * 2 <= WS_W, "ws map");
constexpr int CW_BAR = 4096;

constexpr int RING_BYTES = 131072;
constexpr int LDSCTL_OFF = RING_BYTES, MISC_OFF = LDSCTL_OFF + 320;
constexpr int LDS_BYTES = 147456;

__device__ __forceinline__ unsigned f2bf(float f) { unsigned u = __builtin_bit_cast(unsigned, f); return (u + 0x7fffu + ((u >> 16) & 1u)) >> 16; }
__device__ __forceinline__ unsigned pk2(float lo, float hi) { return f2bf(lo) | (f2bf(hi) << 16); }
__device__ __forceinline__ unsigned cvt_pk_bf16(float lo, float hi) { unsigned r; asm volatile("v_cvt_pk_bf16_f32 %0, %1, %2" : "=v"(r) : "v"(lo), "v"(hi)); return r; }
__device__ __forceinline__ int lane_id() { int l; asm volatile("v_mbcnt_lo_u32_b32 %0, -1, 0\n\tv_mbcnt_hi_u32_b32 %0, -1, %0" : "=v"(l)); return l; }
#define MY_TID(wave_) (((wave_) << 6) | lane_id())
__device__ __forceinline__ float wave_sum(float v) {
#pragma unroll
    for (int o = 1; o < 64; o <<= 1) v += __shfl_xor(v, o);
    return v;
}

namespace pg8 {
constexpr int BM = 256, BK = 64, HALF = 128, HTB = HALF * BK * 2, STAGE_BYTES = 8 * HTB, NXCD = 8, WGM = 4;
__host__ __device__ __forceinline__ int lds_byte(int r, int c) { const int st = (r >> 4) * 2 + (c >> 5), rr = r & 15, cc = c & 31, ob = rr * 64 + cc * 2; return st * 1024 + (ob ^ (((ob >> 9) & 1) << 5)); }
__host__ __device__ __forceinline__ void stage_rc(int b, int& R, int& C) { const int st = b / 1024, sb = b % 1024, swz = sb ^ (((sb >> 9) & 1) << 5); R = (st >> 1) * 16 + swz / 64; C = (st & 1) * 32 + (swz % 64) / 2; }
__host__ __device__ __forceinline__ int perm32(int rho) { const int n = rho >> 4, i = rho & 15; return 8 * (i >> 2) + 4 * n + (i & 3); }

struct Unit { int pm, pn; };
struct Gemm { const bf16_t* A; const bf16_t* Bt; int M, N, K, lda, ldb; };

struct StaticOrder {
    int nM, nN, nwg, G, c;
    struct Pos { int L, gid, rem; };
    __device__ bool step(Pos& p, Unit& u) const {
        p.L += G; if (p.L >= nwg) return false;
        const int nig = WGM * nN; p.rem += G >> 3;
        while (p.rem >= nig) { p.rem -= nig; ++p.gid; }
        u.pm = p.gid * WGM + (p.rem & (WGM - 1)); u.pn = p.rem / WGM; return true;
    }
    __device__ bool first(Pos& p, Unit& u) const {
        p.L = c; if (p.L >= nwg) return false;
        const int wgid = (p.L & 7) * (nwg >> 3) + (p.L >> 3), nig = WGM * nN;
        p.gid = wgid / nig; p.rem = wgid - p.gid * nig;
        u.pm = p.gid * WGM + (p.rem & (WGM - 1)); u.pn = p.rem / WGM; return true;
    }
    __device__ void init(int M_, int N_, int G_, int c_) { nM = M_ / BM; nN = N_ / BM; nwg = nM * nN; G = G_; c = c_; }
    __device__ bool next(int i, Unit& u) const {
        const long L = (long)i * G + c; if (L >= nwg) return false;
        int wgid = (int)L; { const int q = nwg / NXCD, r = nwg % NXCD, xcd = wgid % NXCD, off = wgid / NXCD; wgid = (xcd < r ? xcd * (q + 1) : r * (q + 1) + (xcd - r) * q) + off; }
        const int nig = WGM * nN, gid = wgid / nig, fm = gid * WGM, gsz = (nM - fm) < WGM ? (nM - fm) : WGM;
        u.pm = fm + ((wgid % nig) % gsz); u.pn = (wgid % nig) / gsz; return true;
    }
};

__device__ __forceinline__ const char* uptr(const char* p) {
    const unsigned long long v = (unsigned long long)p;
    const unsigned lo = (unsigned)__builtin_amdgcn_readfirstlane((int)(unsigned)v), hi = (unsigned)__builtin_amdgcn_readfirstlane((int)(unsigned)(v >> 32));
    return (const char*)(((unsigned long long)hi << 32) | lo);
}
template <int OFF> __device__ __forceinline__ f32x4 lds_rd128f(int addr) { f32x4 r; asm volatile("ds_read_b128 %0, %1 offset:%2" : "=&v"(r) : "v"(addr), "i"(OFF) : "memory"); return r; }
template <class Epi>
__device__ __forceinline__ void gemm_phase(LAS unsigned char* lds, const Gemm g, const StaticOrder& S, const Epi& E, const int wave) {
    int tid_ = MY_TID(wave); asm volatile("" : "+v"(tid_));
    const int tid = tid_, wid = __builtin_amdgcn_readfirstlane(tid >> 6), lane = tid & 63, wr = wid >> 2, wc = wid & 3, fr = lane & 15, fq = lane >> 4;
    const int K = g.K, nt = K / BK;
    unsigned voffA[2], voffB[2];
#pragma unroll
    for (int i = 0; i < 2; ++i) { int R, C; stage_rc(tid * 16 + i * 8192, R, C); const int Rb = (R & ~31) + perm32(R & 31);
        voffA[i] = (unsigned)(R * g.lda + C) * 2u; voffB[i] = (unsigned)(Rb * g.ldb + C) * 2u; }
    const size_t kstep = (size_t)(BK * 2);
    const size_t hstepA = (size_t)HALF * g.lda * 2, hstepB = (size_t)HALF * g.ldb * 2;
    const size_t tstepA = 2 * hstepA, tstepB = 2 * hstepB;
    const unsigned ldsw = (unsigned)wid * 1024u;
    const int aoff = lds_byte(wr * 64 + fr, fq * 8), boff = lds_byte(wc * 32 + fr, fq * 8);
#define PG8_SA(b, h) (((b) * 2 + (h)) * HTB)
#define PG8_SB(b, h) ((4 + (b) * 2 + (h)) * HTB)
#define PG8_STAGE(bufoff, gbase, voff) do { const char* gb__ = uptr((const char*)(gbase)); _Pragma("unroll") for (int _i = 0; _i < 2; ++_i) { asm volatile("" : "+v"((voff)[_i])); \
        __builtin_amdgcn_global_load_lds((const unsigned*)(gb__ + (voff)[_i]), (LAS unsigned*)(lds + (bufoff) + ldsw + _i * 8192), 16, 0, 0); } } while (0)
#define PG8_LDA(dst, b, h) do { _Pragma("unroll") for (int m = 0; m < 4; ++m) _Pragma("unroll") for (int k = 0; k < 2; ++k) dst[m][k] = *(const LAS bf16x8*)(lds + PG8_SA(b, h) + aoff + m * 2048 + k * 1024); } while (0)
#define PG8_LDB(dst, b, h) do { _Pragma("unroll") for (int n = 0; n < 2; ++n) _Pragma("unroll") for (int k = 0; k < 2; ++k) dst[n][k] = *(const LAS bf16x8*)(lds + PG8_SB(b, h) + boff + n * 2048 + k * 1024); } while (0)
#define PG8_MMA(ai, bj, At, Bt) do { __builtin_amdgcn_s_setprio(3); _Pragma("unroll") for (int m = 0; m < 4; ++m) _Pragma("unroll") for (int n = 0; n < 2; ++n) _Pragma("unroll") for (int k = 0; k < 2; ++k) \
        acc[ai][bj][m][n] = __builtin_amdgcn_mfma_f32_16x16x32_bf16(Bt[n][k], At[m][k], acc[ai][bj][m][n], 0, 0, 0); __builtin_amdgcn_s_setprio(0); } while (0)
#define PG8_MMAZ(ai, bj, At, Bt) do { __builtin_amdgcn_s_setprio(3); _Pragma("unroll") for (int m = 0; m < 4; ++m) _Pragma("unroll") for (int n = 0; n < 2; ++n) { \
        acc[ai][bj][m][n] = __builtin_amdgcn_mfma_f32_16x16x32_bf16(Bt[n][0], At[m][0], (f32x4){0.f, 0.f, 0.f, 0.f}, 0, 0, 0); \
        acc[ai][bj][m][n] = __builtin_amdgcn_mfma_f32_16x16x32_bf16(Bt[n][1], At[m][1], acc[ai][bj][m][n], 0, 0, 0); } __builtin_amdgcn_s_setprio(0); } while (0)
#define PG8_WAIT_V(n) asm volatile("s_waitcnt vmcnt(" #n ")" ::: "memory")
#define PG8_WAIT_L(n) asm volatile("s_waitcnt lgkmcnt(" #n ")" ::: "memory")
#define PG8_BAR __builtin_amdgcn_s_barrier()
#define PG8_SCHED __builtin_amdgcn_sched_barrier(0)
    Unit cur, nxt; int ui = 0;
    const bool incr = ((S.nwg | S.G) & 7) == 0 && (S.nM % WGM) == 0;
    StaticOrder::Pos pos;
    if (incr) { if (!S.first(pos, cur)) return; } else if (!S.next(0, cur)) return;
    constexpr int RS_LDS = LDSCTL_OFF + 8192;
#define PG8_RS_DMA(pm_) do { if constexpr (Epi::RSTD) { unsigned vo__ = (unsigned)tid * 16u; asm volatile("" : "+v"(vo__)); \
        __builtin_amdgcn_global_load_lds((const unsigned*)((const char*)E.rs_src() + (size_t)(pm_) * 8192 + vo__), (LAS unsigned*)(lds + RS_LDS + ldsw), 16, 0, 0); } } while (0)
    PG8_RS_DMA(cur.pm);
    f32x4 acc[2][2][4][2];
    bf16x8 At[4][2], B0[2][2], B1[2][2];
    const char* cA = (const char*)g.A + (size_t)cur.pm * tstepA; const char* cB = (const char*)g.Bt + (size_t)cur.pn * tstepB;
    PG8_STAGE(PG8_SB(0, 0), cB, voffB); PG8_STAGE(PG8_SB(0, 1), cB + hstepB, voffB); PG8_STAGE(PG8_SA(0, 0), cA, voffA); PG8_STAGE(PG8_SA(0, 1), cA + hstepA, voffA);
    if (wr == 1) PG8_BAR;
    PG8_WAIT_V(2); PG8_BAR;
    PG8_STAGE(PG8_SB(1, 0), cB + kstep, voffB); PG8_STAGE(PG8_SA(1, 0), cA + kstep, voffA); PG8_STAGE(PG8_SB(1, 1), cB + hstepB + kstep, voffB);
    PG8_WAIT_V(6); PG8_BAR;
    for (;;) {
        const bool has_next = incr ? S.step(pos, nxt) : S.next(ui + 1, nxt);
        const char* nA = has_next ? (const char*)g.A + (size_t)nxt.pm * tstepA : cA; const char* nB = has_next ? (const char*)g.Bt + (size_t)nxt.pn * tstepB : cB;
#define PG8_ITER(MMA0_, W12_) do { \
            const bool last = (t == nt - 2); \
            const char* a1 = cA + (size_t)(t + 1) * kstep; \
            const char* a2 = last ? nA : cA + (size_t)(t + 2) * kstep; const char* b2 = last ? nB : cB + (size_t)(t + 2) * kstep; \
            const char* a3 = a2 + kstep; const char* b3 = b2 + kstep; \
            PG8_LDB(B0, 0, 0); PG8_LDB(B1, 0, 1); PG8_SCHED; PG8_LDA(At, 0, 0); PG8_STAGE(PG8_SA(1, 1), a1 + hstepA, voffA); \
            W12_; PG8_WAIT_L(0); PG8_BAR; MMA0_(0, 0, At, B0); MMA0_(0, 1, At, B1); PG8_BAR; PG8_SCHED; \
            PG8_LDA(At, 0, 1); PG8_STAGE(PG8_SB(0, 0), b2, voffB); PG8_STAGE(PG8_SB(0, 1), b2 + hstepB, voffB); PG8_STAGE(PG8_SA(0, 0), a2, voffA); \
            W12_; PG8_WAIT_L(0); PG8_BAR; MMA0_(1, 0, At, B0); MMA0_(1, 1, At, B1); PG8_BAR; PG8_SCHED; \
            PG8_LDB(B0, 1, 0); PG8_LDB(B1, 1, 1); PG8_SCHED; PG8_LDA(At, 1, 0); PG8_STAGE(PG8_SA(0, 1), a2 + hstepA, voffA); \
            PG8_WAIT_V(8); PG8_WAIT_L(0); PG8_BAR; PG8_MMA(0, 0, At, B0); PG8_MMA(0, 1, At, B1); PG8_BAR; PG8_SCHED; \
            PG8_LDA(At, 1, 1); PG8_STAGE(PG8_SB(1, 0), b3, voffB); PG8_STAGE(PG8_SB(1, 1), b3 + hstepB, voffB); PG8_STAGE(PG8_SA(1, 0), a3, voffA); \
            PG8_WAIT_V(8); PG8_WAIT_L(0); PG8_BAR; PG8_MMA(1, 0, At, B0); PG8_MMA(1, 1, At, B1); PG8_BAR; PG8_SCHED; } while (0)
#define PG8_W12_RELAX do { if (relax) asm volatile("s_waitcnt vmcnt(%0)" :: "i"(8 + Epi::EPI_VM) : "memory"); else PG8_WAIT_V(8); } while (0)
        { const int t = 0; const bool relax = __builtin_amdgcn_readfirstlane((int)(ui > 0)) != 0; PG8_ITER(PG8_MMAZ, PG8_W12_RELAX); }
        for (int t = 2; t < nt; t += 2) PG8_ITER(PG8_MMA, PG8_WAIT_V(8));
#undef PG8_W12_RELAX
#undef PG8_ITER
        if (wr == 0) PG8_BAR;
        { int tz = MY_TID(wave); asm volatile("" : "+v"(tz));
          const int wid2 = tz >> 6, lane2 = tz & 63;
          if constexpr (Epi::RSTD) {
              float rs[8];
              { const int ra = (int)(uintptr_t)lds + RS_LDS + ((wid2 >> 2) * 64 + (lane2 & 15)) * 32;
                f32x4 sa[8], sb[8];
#define PG8_RS_RD(k, OFF) sa[k] = lds_rd128f<(OFF) * 32>(ra); sb[k] = lds_rd128f<(OFF) * 32 + 16>(ra)
                PG8_RS_RD(0, 0); PG8_RS_RD(1, 16); PG8_RS_RD(2, 32); PG8_RS_RD(3, 48); PG8_RS_RD(4, 128); PG8_RS_RD(5, 144); PG8_RS_RD(6, 160); PG8_RS_RD(7, 176);
#undef PG8_RS_RD
                asm volatile("s_waitcnt lgkmcnt(0)" : "+v"(sa[0]), "+v"(sa[1]), "+v"(sa[2]), "+v"(sa[3]), "+v"(sa[4]), "+v"(sa[5]), "+v"(sa[6]), "+v"(sa[7]),
                                                        "+v"(sb[0]), "+v"(sb[1]), "+v"(sb[2]), "+v"(sb[3]), "+v"(sb[4]), "+v"(sb[5]), "+v"(sb[6]), "+v"(sb[7]) :: "memory");
#pragma unroll
                for (int k = 0; k < 8; ++k) { const float s = ((sa[k].x + sa[k].y) + (sa[k].z + sa[k].w)) + ((sb[k].x + sb[k].y) + (sb[k].z + sb[k].w)); rs[k] = __builtin_amdgcn_rsqf(s * Epi::INV_N + RMS_EPS); } }
              PG8_BAR;
              E.run_rs(acc, cur, wid2 >> 2, wid2 & 3, lane2 & 15, lane2 >> 4, rs);
              if (has_next) PG8_RS_DMA(nxt.pm);
          }
          else E(acc, cur, wid2 >> 2, wid2 & 3, lane2 & 15, lane2 >> 4);
          if (Epi::PROBE2 && PROBE_EPI > 1) { asm volatile("" : "+v"(tz)); const int wid3 = tz >> 6, lane3 = tz & 63; E.second(acc, cur, wid3 >> 2, wid3 & 3, lane3 & 15, lane3 >> 4); } }
        if (!has_next) break;
        cur = nxt; cA = nA; cB = nB; ++ui;
        if (wr == 1) PG8_BAR;
    }
    PG8_WAIT_V(0);
    PG8_BAR;
#undef PG8_RS_DMA
#undef PG8_SA
#undef PG8_SB
#undef PG8_STAGE
#undef PG8_LDA
#undef PG8_LDB
#undef PG8_MMA
#undef PG8_MMAZ
#undef PG8_WAIT_V
#undef PG8_WAIT_L
#undef PG8_BAR
#undef PG8_SCHED
}
}

__device__ __forceinline__ float rsq(float x) { return __builtin_amdgcn_rsqf(x); }
constexpr float QS128 = 0.08838834764831845f * 1.4426950408889634f;
constexpr float QS192 = 0.07216878364870322f * 1.4426950408889634f;
__device__ __forceinline__ void rstd8_8(const float* ss, int row0, float inv_n, float (&rs)[8]) {
#pragma unroll
    for (int h = 0; h < 2; ++h) {
        f32x4 a[4], b[4];
#pragma unroll
        for (int i = 0; i < 4; ++i) { const f32x4* p = (const f32x4*)(ss + (size_t)(row0 + h * 128 + i * 16) * 8); a[i] = p[0]; b[i] = p[1]; }
#pragma unroll
        for (int i = 0; i < 4; ++i) { const float s = ((a[i].x + a[i].y) + (a[i].z + a[i].w)) + ((b[i].x + b[i].y) + (b[i].z + b[i].w)); rs[h * 4 + i] = rsq(s * inv_n + RMS_EPS); }
        asm volatile("" : "+v"(rs[h * 4 + 0]), "+v"(rs[h * 4 + 1]), "+v"(rs[h * 4 + 2]), "+v"(rs[h * 4 + 3]));
    }
}
__device__ __forceinline__ void rs_issue(const float* ss, int row0, int h, f32x4 (&a)[4], f32x4 (&b)[4]) {
#pragma unroll
    for (int i = 0; i < 4; ++i) { const f32x4* p = (const f32x4*)(ss + (size_t)(row0 + h * 128 + i * 16) * 8); a[i] = p[0]; b[i] = p[1]; }
}
__device__ __forceinline__ void rs_finish(const f32x4 (&a)[4], const f32x4 (&b)[4], float inv_n, float* rs) {
#pragma unroll
    for (int i = 0; i < 4; ++i) { const float s = ((a[i].x + a[i].y) + (a[i].z + a[i].w)) + ((b[i].x + b[i].y) + (b[i].z + b[i].w)); rs[i] = rsq(s * inv_n + RMS_EPS); }
}
__device__ __forceinline__ u32x4 pack8(const f32x4 v0, const f32x4 v1) {
    u32x4 w; w.x = cvt_pk_bf16(v0[0], v0[1]); w.y = cvt_pk_bf16(v0[2], v0[3]); w.z = cvt_pk_bf16(v1[0], v1[1]); w.w = cvt_pk_bf16(v1[2], v1[3]); return w;
}
__device__ __forceinline__ float sq4(const f32x4 v) { return (v[0] * v[0] + v[1] * v[1]) + (v[2] * v[2] + v[3] * v[3]); }

template <int SRC> struct EpiScaleBf16 {
    static constexpr bool PROBE2 = (PROBE_EPI_WHICH == 1) && (SRC == 1), PREFETCH = false, RSTD = (SRC != 0);
    static constexpr int EPI_VM = 16 + (SRC != 0 ? 1 : 0);
    static constexpr float INV_N = (SRC == 1) ? 1.0f / 2048.0f : 1.0f / 512.0f;
    bf16_t* O; int ldc; const float* ss;
    __device__ __forceinline__ const float* rs_src() const { return ss; }
    __device__ __forceinline__ void run_rs(const f32x4 (&acc)[2][2][4][2], const pg8::Unit& u, int wr, int wc, int fr, int fq, const float (&rs)[8]) const { store(acc, u, wr, wc, fr, fq, rs, 0); store(acc, u, wr, wc, fr, fq, rs, 1); }
    __device__ __forceinline__ void rs_first(const pg8::Unit& u, int wr, int fr, float (&rs)[8]) const { rstd8_8(ss, u.pm * 256 + wr * 64 + fr, INV_N, rs); }
    __device__ __forceinline__ void second(const f32x4 (&acc)[2][2][4][2], const pg8::Unit& u, int wr, int wc, int fr, int fq) const { float rs[8]; rs_first(u, wr, fr, rs); store(acc, u, wr, wc, fr, fq, rs, 0); store(acc, u, wr, wc, fr, fq, rs, 1); }
    __device__ __forceinline__ void store(const f32x4 (&acc)[2][2][4][2], const pg8::Unit& u, int wr, int wc, int fr, int fq, const float (&rs)[8], const int ai) const {
        const int row0 = u.pm * 256 + wr * 64 + fr, col0 = u.pn * 256 + wc * 32 + 8 * fq;
        const float qs = (SRC == 1 && (u.pn < 6 || u.pn >= 18)) ? QS128 : 1.0f;
#pragma unroll
        for (int m = 0; m < 4; ++m) { bf16_t* rowp = O + (size_t)(row0 + ai * 128 + m * 16) * ldc + col0; const float s = SRC ? rs[ai * 4 + m] * qs : 1.0f;
#pragma unroll
            for (int bj = 0; bj < 2; ++bj) *(u32x4*)(rowp + bj * 128) = pack8(acc[ai][bj][m][0] * s, acc[ai][bj][m][1] * s); }
    }
    __device__ __forceinline__ void operator()(const f32x4 (&acc)[2][2][4][2], const pg8::Unit& u, int wr, int wc, int fr, int fq) const {
        float rs[8]; if (SRC) rs_first(u, wr, fr, rs); store(acc, u, wr, wc, fr, fq, rs, 0); store(acc, u, wr, wc, fr, fq, rs, 1);
    }
    __device__ __forceinline__ void run(const f32x4 (&acc)[2][2][4][2], const pg8::Unit& u, int wr, int wc, int fr, int fq, const float (&rs)[8], bool has_next, const pg8::Unit& nx, float (&rsn)[8]) const {
        const int nrow0 = nx.pm * 256 + wr * 64 + fr;
        f32x4 na[4], nb[4];
        if (has_next) rs_issue(ss, nrow0, 0, na, nb);
        store(acc, u, wr, wc, fr, fq, rs, 0);
        if (has_next) { rs_finish(na, nb, INV_N, &rsn[0]); asm volatile("" : "+v"(rsn[0]), "+v"(rsn[1]), "+v"(rsn[2]), "+v"(rsn[3])); rs_issue(ss, nrow0, 1, na, nb); }
        store(acc, u, wr, wc, fr, fq, rs, 1);
        if (has_next) { rs_finish(na, nb, INV_N, &rsn[4]); asm volatile("" : "+v"(rsn[4]), "+v"(rsn[5]), "+v"(rsn[6]), "+v"(rsn[7])); }
    }
};
__device__ __forceinline__ f32x4 bf2f_lo(const u32x4 w) { return (f32x4){__uint_as_float(w.x << 16), __uint_as_float(w.x & 0xffff0000u), __uint_as_float(w.y << 16), __uint_as_float(w.y & 0xffff0000u)}; }
__device__ __forceinline__ f32x4 bf2f_hi(const u32x4 w) { return (f32x4){__uint_as_float(w.z << 16), __uint_as_float(w.z & 0xffff0000u), __uint_as_float(w.w << 16), __uint_as_float(w.w & 0xffff0000u)}; }
template <bool INF32, bool OUTF32> struct EpiResid {
    static constexpr bool PROBE2 = (PROBE_EPI_WHICH == 2) && !INF32 && !OUTF32, PREFETCH = false, RSTD = false;
    static constexpr int EPI_VM = 16;
    const float* hin; float* hout; bf16_t* hb; float* ss; LAS float* red;
    __device__ __forceinline__ void operator()(const f32x4 (&acc)[2][2][4][2], const pg8::Unit& u, int wr, int wc, int fr, int fq) const { run(acc, u, wr, wc, fr, fq, 1.0f); }
    __device__ __forceinline__ void second(const f32x4 (&acc)[2][2][4][2], const pg8::Unit& u, int wr, int wc, int fr, int fq) const { run(acc, u, wr, wc, fr, fq, 0.0f); }
    __device__ __forceinline__ void run(const f32x4 (&acc)[2][2][4][2], const pg8::Unit& u, int wr, int wc, int fr, int fq, const float sc) const {
        const int row0 = u.pm * 256 + wr * 64 + fr, col0 = u.pn * 256 + wc * 32 + 8 * fq;
        constexpr int NB = INF32 ? 2 : 1, AB = 2 / NB;
#pragma unroll
        for (int b = 0; b < NB; ++b) {
            u32x4 hw[AB][4][2]; f32x4 ha[AB][4][2], hc[AB][4][2];
#pragma unroll
            for (int a2 = 0; a2 < AB; ++a2)
#pragma unroll
                for (int m = 0; m < 4; ++m)
#pragma unroll
                    for (int bj = 0; bj < 2; ++bj) { const int ai = b * AB + a2; const size_t off = (size_t)(row0 + ai * 128 + m * 16) * DM + col0 + bj * 128;
                        if (INF32) { ha[a2][m][bj] = *(const f32x4*)(hin + off); hc[a2][m][bj] = *(const f32x4*)(hin + off + 4); }
                        else hw[a2][m][bj] = *(const u32x4*)(hb + off); }
#pragma unroll
            for (int a2 = 0; a2 < AB; ++a2) { const int ai = b * AB + a2;
#pragma unroll
                for (int m = 0; m < 4; ++m) { const int row = row0 + ai * 128 + m * 16; const size_t off = (size_t)row * DM + col0; float q = 0.f;
#pragma unroll
                    for (int bj = 0; bj < 2; ++bj) {
                        const f32x4 r0 = INF32 ? ha[a2][m][bj] : bf2f_lo(hw[a2][m][bj]), r1 = INF32 ? hc[a2][m][bj] : bf2f_hi(hw[a2][m][bj]);
                        const f32x4 v0 = PROBE2 ? r0 + acc[ai][bj][m][0] * sc : r0 + acc[ai][bj][m][0], v1 = PROBE2 ? r1 + acc[ai][bj][m][1] * sc : r1 + acc[ai][bj][m][1];
                        if (OUTF32) { *(f32x4*)(hout + off + bj * 128) = v0; *(f32x4*)(hout + off + bj * 128 + 4) = v1; }
                        else *(u32x4*)(hb + off + bj * 128) = pack8(v0, v1);
                        q += sq4(v0) + sq4(v1); }
                    q += __shfl_xor(q, 16); q += __shfl_xor(q, 32);
                    if (fq == 0) red[(ai * 128 + wr * 64 + m * 16 + fr) * 4 + wc] = q; }
            }
        }
        asm volatile("s_waitcnt lgkmcnt(0)" ::: "memory"); __builtin_amdgcn_s_barrier(); asm volatile("" ::: "memory");
        int tz = ((wr * 4 + wc) << 6) | (fq * 16 + fr); asm volatile("" : "+v"(tz));
        if (tz < 256) { const f32x4 r = *(const LAS f32x4*)(red + tz * 4); ss[(size_t)(u.pm * 256 + tz) * 8 + u.pn] = (r.x + r.y) + (r.z + r.w); }
    }
};
struct EpiSwiglu {
    static constexpr bool PROBE2 = (PROBE_EPI_WHICH == 0), PREFETCH = false, RSTD = true;
    static constexpr int EPI_VM = 8 + 1;
    static constexpr float INV_N = 1.0f / 2048.0f;
    bf16_t* H; const float* ss; int coloff;
    __device__ __forceinline__ const float* rs_src() const { return ss; }
    __device__ __forceinline__ void run_rs(const f32x4 (&acc)[2][2][4][2], const pg8::Unit& u, int wr, int wc, int fr, int fq, const float (&rs)[8]) const { half(acc, u, wr, wc, fr, fq, rs, 0); half(acc, u, wr, wc, fr, fq, rs, 1); }
    __device__ __forceinline__ void rs_first(const pg8::Unit& u, int wr, int fr, float (&rs)[8]) const { rstd8_8(ss, u.pm * 256 + wr * 64 + fr, 1.0f / 2048.0f, rs); }
    __device__ __forceinline__ void second(const f32x4 (&acc)[2][2][4][2], const pg8::Unit& u, int wr, int wc, int fr, int fq) const { float rs[8]; rs_first(u, wr, fr, rs); half(acc, u, wr, wc, fr, fq, rs, 0); half(acc, u, wr, wc, fr, fq, rs, 1); }
    __device__ __forceinline__ void operator()(const f32x4 (&acc)[2][2][4][2], const pg8::Unit& u, int wr, int wc, int fr, int fq) const { second(acc, u, wr, wc, fr, fq); }
    __device__ __forceinline__ void half(const f32x4 (&acc)[2][2][4][2], const pg8::Unit& u, int wr, int wc, int fr, int fq, const float (&rs)[8], const int ai) const {
        const int row0 = u.pm * 256 + wr * 64 + fr, col0 = coloff + u.pn * 128 + wc * 32 + 8 * fq;
#pragma unroll
        for (int m = 0; m < 4; ++m) { const float s = rs[ai * 4 + m], sn = s * -1.4426950408889634f, s2 = s * s; f32x4 o[2];
#pragma unroll
            for (int n = 0; n < 2; ++n) { const f32x4 g = acc[ai][0][m][n]; const f32x4 t = g * sn; const f32x4 gu = g * acc[ai][1][m][n]; f32x4 r;
#pragma unroll
                for (int j = 0; j < 4; ++j) r[j] = __builtin_amdgcn_rcpf(1.0f + __builtin_amdgcn_exp2f(t[j]));
                o[n] = gu * (r * s2); }
            __builtin_nontemporal_store(pack8(o[0], o[1]), (u32x4*)(H + (size_t)(row0 + ai * 128 + m * 16) * FFN + col0)); }
    }
    __device__ __forceinline__ void run(const f32x4 (&acc)[2][2][4][2], const pg8::Unit& u, int wr, int wc, int fr, int fq, const float (&rs)[8], bool has_next, const pg8::Unit& nx, float (&rsn)[8]) const {
        const int nrow0 = nx.pm * 256 + wr * 64 + fr;
        f32x4 na[4], nb[4];
        if (has_next) rs_issue(ss, nrow0, 0, na, nb);
        half(acc, u, wr, wc, fr, fq, rs, 0);
        if (has_next) { rs_finish(na, nb, 1.0f / 2048.0f, &rsn[0]); asm volatile("" : "+v"(rsn[0]), "+v"(rsn[1]), "+v"(rsn[2]), "+v"(rsn[3])); rs_issue(ss, nrow0, 1, na, nb); }
        half(acc, u, wr, wc, fr, fq, rs, 1);
        if (has_next) { rs_finish(na, nb, 1.0f / 2048.0f, &rsn[4]); asm volatile("" : "+v"(rsn[4]), "+v"(rsn[5]), "+v"(rsn[6]), "+v"(rsn[7])); }
    }
};
struct EpiNull {
    static constexpr bool PROBE2 = false, PREFETCH = false, RSTD = false;
    static constexpr int EPI_VM = 0;
    __device__ __forceinline__ void second(const f32x4 (&acc)[2][2][4][2], const pg8::Unit& u, int wr, int wc, int fr, int fq) const {}
    float* sink;
    __device__ __forceinline__ void operator()(const f32x4 (&acc)[2][2][4][2], const pg8::Unit& u, int wr, int wc, int fr, int fq) const {
        f32x4 s = (f32x4){0.f, 0.f, 0.f, 0.f};
#pragma unroll
        for (int ai = 0; ai < 2; ++ai)
#pragma unroll
            for (int bj = 0; bj < 2; ++bj)
#pragma unroll
                for (int m = 0; m < 4; ++m) { s += acc[ai][bj][m][0]; s += acc[ai][bj][m][1]; }
        const float t = (s.x + s.y) + (s.z + s.w);
        if (t != t) sink[0] = t;
    }
};
__device__ __forceinline__ void rope4(f32x4& x1, f32x4& x2, const float* cosT, const float* sinT, int row, int i0) {
    const f32x4 c = *(const f32x4*)(cosT + (size_t)row * 32 + i0), s = *(const f32x4*)(sinT + (size_t)row * 32 + i0);
    const f32x4 o1 = x1 * c - x2 * s, o2 = x2 * c + x1 * s; x1 = o1; x2 = o2;
}
struct EpiBIn {
    static constexpr bool PROBE2 = false, PREFETCH = false, RSTD = true;
    static constexpr int EPI_VM = 0;
    static constexpr float INV_N = 1.0f / 2048.0f;
    __device__ __forceinline__ void second(const f32x4 (&acc)[2][2][4][2], const pg8::Unit& u, int wr, int wc, int fr, int fq) const {}
    bf16_t* pb; bf16_t* kr; const float* ss; float* ssq; float* ssl; const float* cosT; const float* sinT;
    __device__ __forceinline__ const float* rs_src() const { return ss; }
    __device__ __forceinline__ void run_rs(const f32x4 (&acc)[2][2][4][2], const pg8::Unit& u, int wr, int wc, int fr, int fq, const float (&rs)[8]) const {
        const int row0 = u.pm * 256 + wr * 64 + fr, col0 = u.pn * 256 + wc * 32 + 8 * fq, pn = u.pn;
        if (pn < 6) {
            const bool want = (pn < 2) || (pn >= 4); float* sqp = (pn < 2) ? ssq : ssl; const int slot = (pn & 1) * 4 + wc;
#pragma unroll
            for (int ai = 0; ai < 2; ++ai)
#pragma unroll
                for (int m = 0; m < 4; ++m) { const int row = row0 + ai * 128 + m * 16; const float s = rs[ai * 4 + m] * (want ? 1.0f : QS128); float q = 0.f;
#pragma unroll
                    for (int bj = 0; bj < 2; ++bj) { const f32x4 v0 = acc[ai][bj][m][0] * s, v1 = acc[ai][bj][m][1] * s;
                        *(u32x4*)(pb + (size_t)row * PB_LD + col0 + bj * 128) = pack8(v0, v1); q += sq4(v0) + sq4(v1); }
                    q += __shfl_xor(q, 16); q += __shfl_xor(q, 32);
                    if (want && fq == 0) sqp[(size_t)row * 8 + slot] = q; }
        } else if (wc < 2) {
            const int i0 = 4 * (4 * wc + fq);
#pragma unroll
            for (int ai = 0; ai < 2; ++ai)
#pragma unroll
                for (int m = 0; m < 4; ++m) { const int row = row0 + ai * 128 + m * 16; const float s = rs[ai * 4 + m];
                    f32x4 x1 = acc[ai][0][m][0] * s, x2 = acc[ai][0][m][1] * s; rope4(x1, x2, cosT, sinT, row, i0);
                    *(u32x4*)(kr + (size_t)row * 64 + wc * 32 + 8 * fq) = pack8(x1, x2); }
        }
    }
};
struct EpiUq {
    static constexpr bool PROBE2 = false, PREFETCH = false, RSTD = true;
    static constexpr int EPI_VM = 16 + 1;
    static constexpr float INV_N = 1.0f / 512.0f;
    __device__ __forceinline__ void second(const f32x4 (&acc)[2][2][4][2], const pg8::Unit& u, int wr, int wc, int fr, int fq) const {}
    bf16_t* q; const float* ssq; const float* cosT; const float* sinT;
    __device__ __forceinline__ const float* rs_src() const { return ssq; }
    __device__ __forceinline__ void run_rs(const f32x4 (&acc)[2][2][4][2], const pg8::Unit& u, int wr, int wc, int fr, int fq, const float (&rs)[8]) const {
        const int row0 = u.pm * 256 + wr * 64 + fr, col0 = u.pn * 256 + wc * 32 + 8 * fq;
        const int i0 = 4 * (4 * (wc & 1) + fq);
#pragma unroll
        for (int ai = 0; ai < 2; ++ai)
#pragma unroll
            for (int m = 0; m < 4; ++m) { const int row = row0 + ai * 128 + m * 16; const float s = rs[ai * 4 + m] * QS192;
#pragma unroll
                for (int bj = 0; bj < 2; ++bj) { f32x4 v0 = acc[ai][bj][m][0] * s, v1 = acc[ai][bj][m][1] * s;
                    const int gb = 4 * u.pn + 2 * bj + (wc >> 1);
                    if (gb % 3 == 2) rope4(v0, v1, cosT, sinT, row, i0);
                    *(u32x4*)(q + (size_t)row * UQ_N + col0 + bj * 128) = pack8(v0, v1); } }
    }
};

namespace att {
__device__ __forceinline__ int crow(int r, int hi) { return (r & 3) + 8 * (r >> 2) + 4 * hi; }
__device__ __forceinline__ int key2slot(int k) { const int hi = k >> 5, h = (k >> 4) & 1, r = k & 15; return 32 * h + (r & 3) + 8 * (r >> 2) + 4 * hi; }
__device__ __forceinline__ int slot2key(int s) { const int h = s >> 5, rho = s & 31, hi = (rho >> 2) & 1, r = (rho & 3) | ((rho >> 3) << 2); return 32 * hi + 16 * h + r; }
__device__ __forceinline__ int v_st(int k, int c) { const int kk = (k & ~0xC) | ((k & 4) << 1) | ((k & 8) >> 1); return ((kk >> 3) * 4 + (c >> 5)) * 512 + ((kk & 7) * 32 + (c & 31)) * 2; }
__device__ __forceinline__ int v_rd_base(int lane) { return ((lane & 3) << 3) | (((lane >> 2) & 3) << 6) | (((lane >> 4) & 1) << 5) | (((lane >> 5) & 1) << 8); }
constexpr int v_rd_off(int d0, int ks, int half) { return d0 * 512 + ks * 4096 + half * 2048; }
template <int OFF> __device__ __forceinline__ bf16x8 lds_rd128(int addr) { bf16x8 r; asm volatile("ds_read_b128 %0, %1 offset:%2" : "=&v"(r) : "v"(addr), "i"(OFF) : "memory"); return r; }
__device__ __forceinline__ float lds_rd32(int addr) { float r; asm volatile("ds_read_b32 %0, %1" : "=&v"(r) : "v"(addr) : "memory"); return r; }
__device__ __forceinline__ unsigned lds_rd32u(int addr) { unsigned r; asm volatile("ds_read_b32 %0, %1" : "=&v"(r) : "v"(addr) : "memory"); return r; }
__device__ __forceinline__ void lds_wr32(int addr, float v) { asm volatile("ds_write_b32 %0, %1" :: "v"(addr), "v"(v) : "memory"); }
__device__ __forceinline__ void lds_wr32u(int addr, unsigned v) { asm volatile("ds_write_b32 %0, %1" :: "v"(addr), "v"(v) : "memory"); }
#define ATT_LGKM0() asm volatile("s_waitcnt lgkmcnt(0)" ::: "memory")
template <int OFF> __device__ __forceinline__ s16x4 tr_read(int vb) {
    s16x4 r; asm volatile("ds_read_b64_tr_b16 %0, %1 offset:%2" : "=&v"(r) : "v"(vb), "i"(OFF) : "memory"); return r;
}
struct VFrag { s16x4 l0, h0, l1, h1, l2, h2, l3, h3; };
template <int D0> __device__ __forceinline__ void pv_issue(VFrag& f, int vb) {
    f.l0 = tr_read<v_rd_off(D0, 0, 0)>(vb); f.h0 = tr_read<v_rd_off(D0, 0, 1)>(vb); f.l1 = tr_read<v_rd_off(D0, 1, 0)>(vb); f.h1 = tr_read<v_rd_off(D0, 1, 1)>(vb);
    f.l2 = tr_read<v_rd_off(D0, 2, 0)>(vb); f.h2 = tr_read<v_rd_off(D0, 2, 1)>(vb); f.l3 = tr_read<v_rd_off(D0, 3, 0)>(vb); f.h3 = tr_read<v_rd_off(D0, 3, 1)>(vb);
}
template <int N> __device__ __forceinline__ void pv_wait(VFrag& f) {
    asm volatile("s_waitcnt lgkmcnt(%8)" : "+v"(f.l0), "+v"(f.h0), "+v"(f.l1), "+v"(f.h1), "+v"(f.l2), "+v"(f.h2), "+v"(f.l3), "+v"(f.h3) : "i"(N) : "memory");
    __builtin_amdgcn_sched_barrier(0);
}
__device__ __forceinline__ void pv_mma(f32x16& od, const VFrag& f, bf16x8 pb0, bf16x8 pb1, bf16x8 pb2, bf16x8 pb3) {
#define ATT_PK(L, H) (bf16x8){L[0], L[1], L[2], L[3], H[0], H[1], H[2], H[3]}
    od = __builtin_amdgcn_mfma_f32_32x32x16_bf16(ATT_PK(f.l0, f.h0), pb0, od, 0, 0, 0);
    od = __builtin_amdgcn_mfma_f32_32x32x16_bf16(ATT_PK(f.l1, f.h1), pb1, od, 0, 0, 0);
    od = __builtin_amdgcn_mfma_f32_32x32x16_bf16(ATT_PK(f.l2, f.h2), pb2, od, 0, 0, 0);
    od = __builtin_amdgcn_mfma_f32_32x32x16_bf16(ATT_PK(f.l3, f.h3), pb3, od, 0, 0, 0);
#undef ATT_PK
    __builtin_amdgcn_sched_barrier(0);
}
__device__ __forceinline__ void pv_tile(f32x16 (&o)[4], int vb, bf16x8 pa0, bf16x8 pa1, bf16x8 pa2, bf16x8 pa3) {
    VFrag x, y;
    pv_issue<0>(x, vb); pv_issue<1>(y, vb);
    pv_wait<8>(x); pv_mma(o[0], x, pa0, pa1, pa2, pa3); pv_issue<2>(x, vb);
    pv_wait<8>(y); pv_mma(o[1], y, pa0, pa1, pa2, pa3); pv_issue<3>(y, vb);
    pv_wait<8>(x); pv_mma(o[2], x, pa0, pa1, pa2, pa3);
    pv_wait<0>(y); pv_mma(o[3], y, pa0, pa1, pa2, pa3);
}
__device__ __forceinline__ float sum16(const f32x16& p) {
    float a, b;
    asm volatile("s_nop 0\n\t"
                 "v_add_f32 %0, %2, %3\n\tv_add_f32 %1, %4, %5\n\t"
                 "v_add_f32 %0, %0, %6\n\tv_add_f32 %1, %1, %7\n\t"
                 "v_add_f32 %0, %0, %8\n\tv_add_f32 %1, %1, %9\n\t"
                 "v_add_f32 %0, %0, %10\n\tv_add_f32 %1, %1, %11\n\t"
                 "v_add_f32 %0, %0, %12\n\tv_add_f32 %1, %1, %13\n\t"
                 "v_add_f32 %0, %0, %14\n\tv_add_f32 %1, %1, %15\n\t"
                 "v_add_f32 %0, %0, %16\n\tv_add_f32 %1, %1, %17"
                 : "=&v"(a), "=&v"(b)
                 : "v"(p[0]), "v"(p[1]), "v"(p[2]), "v"(p[3]), "v"(p[4]), "v"(p[5]), "v"(p[6]), "v"(p[7]),
                   "v"(p[8]), "v"(p[9]), "v"(p[10]), "v"(p[11]), "v"(p[12]), "v"(p[13]), "v"(p[14]), "v"(p[15]));
    return a + b;
}
__device__ __forceinline__ void add1_16(f32x16& p) {
    float e0 = p[0], e1 = p[1], e2 = p[2], e3 = p[3], e4 = p[4], e5 = p[5], e6 = p[6], e7 = p[7], e8 = p[8], e9 = p[9], e10 = p[10], e11 = p[11], e12 = p[12], e13 = p[13], e14 = p[14], e15 = p[15];
    asm volatile("s_nop 0\n\t"
                 "v_add_f32 %0, 1.0, %0\n\tv_add_f32 %1, 1.0, %1\n\tv_add_f32 %2, 1.0, %2\n\tv_add_f32 %3, 1.0, %3\n\t"
                 "v_add_f32 %4, 1.0, %4\n\tv_add_f32 %5, 1.0, %5\n\tv_add_f32 %6, 1.0, %6\n\tv_add_f32 %7, 1.0, %7\n\t"
                 "v_add_f32 %8, 1.0, %8\n\tv_add_f32 %9, 1.0, %9\n\tv_add_f32 %10, 1.0, %10\n\tv_add_f32 %11, 1.0, %11\n\t"
                 "v_add_f32 %12, 1.0, %12\n\tv_add_f32 %13, 1.0, %13\n\tv_add_f32 %14, 1.0, %14\n\tv_add_f32 %15, 1.0, %15"
                 : "+v"(e0), "+v"(e1), "+v"(e2), "+v"(e3), "+v"(e4), "+v"(e5), "+v"(e6), "+v"(e7), "+v"(e8), "+v"(e9), "+v"(e10), "+v"(e11), "+v"(e12), "+v"(e13), "+v"(e14), "+v"(e15));
    p = (f32x16){e0, e1, e2, e3, e4, e5, e6, e7, e8, e9, e10, e11, e12, e13, e14, e15};
}
__device__ __forceinline__ void diff16(f32x16& p, float& prev) {
    float e0 = p[0], e1 = p[1], e2 = p[2], e3 = p[3], e4 = p[4], e5 = p[5], e6 = p[6], e7 = p[7], e8 = p[8], e9 = p[9], e10 = p[10], e11 = p[11], e12 = p[12], e13 = p[13], e14 = p[14], e15 = p[15];
    float nprev;
    asm volatile("s_nop 0\n\t"
                 "v_mov_b32 %16, %0\n\t"
                 "v_sub_f32 %0, %1, %0\n\tv_sub_f32 %1, %2, %1\n\tv_sub_f32 %2, %3, %2\n\tv_sub_f32 %3, %4, %3\n\t"
                 "v_sub_f32 %4, %5, %4\n\tv_sub_f32 %5, %6, %5\n\tv_sub_f32 %6, %7, %6\n\tv_sub_f32 %7, %8, %7\n\t"
                 "v_sub_f32 %8, %9, %8\n\tv_sub_f32 %9, %10, %9\n\tv_sub_f32 %10, %11, %10\n\tv_sub_f32 %11, %12, %11\n\t"
                 "v_sub_f32 %12, %13, %12\n\tv_sub_f32 %13, %14, %13\n\tv_sub_f32 %14, %15, %14\n\tv_sub_f32 %15, %17, %15"
                 : "+v"(e0), "+v"(e1), "+v"(e2), "+v"(e3), "+v"(e4), "+v"(e5), "+v"(e6), "+v"(e7), "+v"(e8), "+v"(e9), "+v"(e10), "+v"(e11), "+v"(e12), "+v"(e13), "+v"(e14), "+v"(e15), "=&v"(nprev)
                 : "v"(prev));
    p = (f32x16){e0, e1, e2, e3, e4, e5, e6, e7, e8, e9, e10, e11, e12, e13, e14, e15};
    prev = nprev;
}
__device__ __forceinline__ void cumprod_hi(f32x16& a, f32x16& b) {
    float a8 = a[8], a9 = a[9], a10 = a[10], a11 = a[11], a12 = a[12], a13 = a[13], a14 = a[14], a15 = a[15], b8 = b[8], b9 = b[9], b10 = b[10], b11 = b[11], b12 = b[12], b13 = b[13], b14 = b[14], b15 = b[15];
    asm volatile("v_mul_f32 %6, %7, %6\n\tv_mul_f32 %14, %15, %14\n\tv_mul_f32 %5, %6, %5\n\tv_mul_f32 %13, %14, %13\n\t"
                 "v_mul_f32 %4, %5, %4\n\tv_mul_f32 %12, %13, %12\n\tv_mul_f32 %3, %4, %3\n\tv_mul_f32 %11, %12, %11\n\t"
                 "v_mul_f32 %2, %3, %2\n\tv_mul_f32 %10, %11, %10\n\tv_mul_f32 %1, %2, %1\n\tv_mul_f32 %9, %10, %9\n\t"
                 "v_mul_f32 %0, %1, %0\n\tv_mul_f32 %8, %9, %8"
                 : "+v"(a8), "+v"(a9), "+v"(a10), "+v"(a11), "+v"(a12), "+v"(a13), "+v"(a14), "+v"(a15), "+v"(b8), "+v"(b9), "+v"(b10), "+v"(b11), "+v"(b12), "+v"(b13), "+v"(b14), "+v"(b15));
    a[8] = a8; a[9] = a9; a[10] = a10; a[11] = a11; a[12] = a12; a[13] = a13; a[14] = a14; b[8] = b8; b[9] = b9; b[10] = b10; b[11] = b11; b[12] = b12; b[13] = b13; b[14] = b14;
}
__device__ __forceinline__ void cumprod_lo(f32x16& a, f32x16& b) {
    float a0 = a[0], a1 = a[1], a2 = a[2], a3 = a[3], a4 = a[4], a5 = a[5], a6 = a[6], a7 = a[7], b0 = b[0], b1 = b[1], b2 = b[2], b3 = b[3], b4 = b[4], b5 = b[5], b6 = b[6], b7 = b[7];
    asm volatile("v_mul_f32 %7, %16, %7\n\tv_mul_f32 %15, %17, %15\n\tv_mul_f32 %6, %7, %6\n\tv_mul_f32 %14, %15, %14\n\t"
                 "v_mul_f32 %5, %6, %5\n\tv_mul_f32 %13, %14, %13\n\tv_mul_f32 %4, %5, %4\n\tv_mul_f32 %12, %13, %12\n\t"
                 "v_mul_f32 %3, %4, %3\n\tv_mul_f32 %11, %12, %11\n\tv_mul_f32 %2, %3, %2\n\tv_mul_f32 %10, %11, %10\n\t"
                 "v_mul_f32 %1, %2, %1\n\tv_mul_f32 %9, %10, %9\n\tv_mul_f32 %0, %1, %0\n\tv_mul_f32 %8, %9, %8"
                 : "+v"(a0), "+v"(a1), "+v"(a2), "+v"(a3), "+v"(a4), "+v"(a5), "+v"(a6), "+v"(a7), "+v"(b0), "+v"(b1), "+v"(b2), "+v"(b3), "+v"(b4), "+v"(b5), "+v"(b6), "+v"(b7)
                 : "v"(a[8]), "v"(b[8]));
    a[0] = a0; a[1] = a1; a[2] = a2; a[3] = a3; a[4] = a4; a[5] = a5; a[6] = a6; a[7] = a7; b[0] = b0; b[1] = b1; b[2] = b2; b[3] = b3; b[4] = b4; b[5] = b5; b[6] = b6; b[7] = b7;
}
struct Args { const bf16_t* Q; int ldq; const bf16_t* K; int ldk; const bf16_t* Kr; int ldkr; const bf16_t* V; int ldv; bf16_t* O; int ldo; int q0; int ntiles; int wave; };

constexpr int AK_BUF = 24576, AV_OFF = 2 * AK_BUF, AV_BUF = 16384, AST_OFF = AV_OFF + 2 * AV_BUF, AFLAG_OFF = AST_OFF + 2048;
#define ATT_BAR() do { asm volatile("s_waitcnt lgkmcnt(0)" ::: "memory"); __builtin_amdgcn_s_barrier(); asm volatile("" ::: "memory"); } while (0)
template <int MODE, int DQK>
__device__ __forceinline__ void attn_unit(LAS unsigned char* lds, const Args& a) {
    constexpr int ND = DQK / 16;
    constexpr float THRS = 8.0f * 1.4426950408889634f;
    int tid_ = MY_TID(a.wave); asm volatile("" : "+v"(tid_));
    const int tid = tid_, wid = tid >> 6, lane = tid & 63, r32 = lane & 31, hi = lane >> 5;
    const int grp = __builtin_amdgcn_readfirstlane(wid >> 2);
    const int ldsb = (int)(uintptr_t)lds;
    const int st_a = ldsb + AST_OFF + wid * 256;
    const int fl_a = ldsb + AFLAG_OFF;
    bf16x8 qr[ND];
    { const bf16_t* Qw = a.Q + (size_t)(wid * 32 + r32) * a.ldq + hi * 8;
#pragma unroll
      for (int d0 = 0; d0 < ND; ++d0) qr[d0] = *(const bf16x8*)(Qw + d0 * 16); }
    f32x16 o[4];
#pragma unroll
    for (int d = 0; d < 4; ++d)
#pragma unroll
        for (int r = 0; r < 16; ++r) o[d][r] = 0.f;
    float l_reg = 0.f, carryP = 1.f;
    f32x16 nb;
#pragma unroll
    for (int r = 0; r < 16; ++r) nb[r] = 0.f;
    unsigned voffK[2], voffV[2], voffR;
#pragma unroll
    for (int i = 0; i < 2; ++i) {
        const int A = wid * 2048 + i * 1024 + lane * 16;
        { const int slot = A >> 8, ck = ((A >> 4) & 15) ^ (slot & 15); voffK[i] = (unsigned)(slot2key(slot) * a.ldk + ck * 8) * 2u; }
        { const int sub = A >> 9, within = (A & 511) >> 1, kk = ((sub >> 2) << 3) | (within >> 5), c = ((sub & 3) << 5) | (within & 31);
          const int slot = kk;
          voffV[i] = (unsigned)(slot2key(slot) * a.ldv + c) * 2u; }
    }
    { const int A = wid * 1024 + lane * 16, slot = A >> 7, ck = ((A >> 4) & 7) ^ ((slot >> 1) & 7); voffR = (unsigned)(slot2key(slot) * a.ldkr + ck * 8) * 2u; }
    const int kx = r32 & 15, kxr = (r32 >> 1) & 7;
    int koff[ND];
#pragma unroll
    for (int d0 = 0; d0 < ND; ++d0) { koff[d0] = (d0 < 8) ? (r32 * 256 + (((2 * d0 + hi) ^ kx) << 4)) : (16384 + r32 * 128 + (((2 * (d0 - 8) + hi) ^ kxr) << 4)); asm volatile("" : "+v"(koff[d0])); }
    const int vb0 = (int)(uintptr_t)lds + AV_OFF + v_rd_base(lane);
    const int qpos = a.q0 + wid * 32 + r32, qmax = a.q0 + wid * 32 + 31;
    const int nt0 = a.ntiles; int nt = nt0;
#define ATT_TILE(t_) (((MODE == 0) ? (nt0 - 1 - (t_)) : (t_)) * 64)
#define ATT_DMA(gp_, voff_, ldsoff_) do { asm volatile("" : "+v"(voff_)); __builtin_amdgcn_global_load_lds((const unsigned*)(pg8::uptr((const char*)(gp_)) + (voff_)), (LAS unsigned*)(lds + (ldsoff_)), 16, 0, 0); } while (0)
#define ATT_DMAK(t_) do { const int k0_ = ATT_TILE(t_); const int kb_ = ((t_) & 1) * AK_BUF; const bf16_t* kp_ = a.K + (size_t)k0_ * a.ldk; \
        ATT_DMA(kp_, voffK[0], kb_ + a.wave * 2048); ATT_DMA(kp_, voffK[1], kb_ + a.wave * 2048 + 1024); \
        if (DQK == 192) { const bf16_t* rp_ = a.Kr + (size_t)k0_ * a.ldkr; ATT_DMA(rp_, voffR, kb_ + 16384 + a.wave * 1024); } } while (0)
#define ATT_DMAV(t_) do { const int k0_ = ATT_TILE(t_); const int vo_ = AV_OFF + ((t_) & 1) * AV_BUF; const bf16_t* vp_ = a.V + (size_t)k0_ * a.ldv; \
        ATT_DMA(vp_, voffV[0], vo_ + a.wave * 2048); ATT_DMA(vp_, voffV[1], vo_ + a.wave * 2048 + 1024); } while (0)
    if (MODE == 0 && lane < 2) lds_wr32u(fl_a + (lane * 8 + wid) * 4, 0u);
    ATT_BAR();
    ATT_DMAK(0);
    asm volatile("s_waitcnt vmcnt(0)" ::: "memory");
    ATT_BAR();
#pragma unroll
    for (int d0 = 0; d0 < ND; ++d0) asm volatile("" : "+v"(qr[d0]));
    bool actQ = false, actP = false;
    f32x16 p0, p1;
    if (grp == 1) { if (1 < nt0) ATT_DMAK(1); ATT_DMAV(0); ATT_BAR(); }
    for (int t = 0; t <= nt; ++t) {
        if (grp == 0) { if (t + 1 < nt0) ATT_DMAK(t + 1); if (t < nt0) ATT_DMAV(t); }
        else if (MODE == 0 && t >= 1) {
            unsigned fw[8];
#pragma unroll
            for (int w = 0; w < 8; ++w) fw[w] = lds_rd32u(fl_a + (((t - 1) & 1) * 8 + w) * 4);
            asm volatile("s_waitcnt lgkmcnt(0)" : "+v"(fw[0]), "+v"(fw[1]), "+v"(fw[2]), "+v"(fw[3]), "+v"(fw[4]), "+v"(fw[5]), "+v"(fw[6]), "+v"(fw[7]) :: "memory");
            unsigned alld = 1u;
#pragma unroll
            for (int w = 0; w < 8; ++w) alld &= fw[w];
            if (__builtin_amdgcn_readfirstlane(alld) && t < nt) nt = t;
        }
        if (t >= 1 && actP) {
            const int vb = vb0 + ((t - 1) & 1) * AV_BUF;
            u32x4 w0_ = {__float_as_uint(p0[0]), __float_as_uint(p0[1]), __float_as_uint(p0[2]), __float_as_uint(p0[3])}, w1_ = {__float_as_uint(p0[4]), __float_as_uint(p0[5]), __float_as_uint(p0[6]), __float_as_uint(p0[7])};
            u32x4 w2_ = {__float_as_uint(p0[8]), __float_as_uint(p0[9]), __float_as_uint(p0[10]), __float_as_uint(p0[11])}, w3_ = {__float_as_uint(p0[12]), __float_as_uint(p0[13]), __float_as_uint(p0[14]), __float_as_uint(p0[15])};
            const bf16x8 pa0 = __builtin_bit_cast(bf16x8, w0_), pa1 = __builtin_bit_cast(bf16x8, w1_), pa2 = __builtin_bit_cast(bf16x8, w2_), pa3 = __builtin_bit_cast(bf16x8, w3_);
            pv_tile(o, vb, pa0, pa1, pa2, pa3);
        }
        actQ = false;
        if (t < nt) {
            const int k0 = ATT_TILE(t);
            if (MODE == 0) actQ = (k0 < qmax) && !__all(carryP > 1e30f);
            else if (MODE == 1) actQ = (k0 <= qmax);
            else actQ = true;
            if (actQ) {
                const int K_a = ldsb + (t & 1) * AK_BUF;
#pragma unroll
                for (int r = 0; r < 16; ++r) { p0[r] = (MODE == 0) ? 0.f : nb[r]; p1[r] = (MODE == 0) ? 0.f : nb[r]; }
                constexpr int NC = ND / 2;
                bf16x8 xa[2], xb[2], ya[2], yb[2];
#define ATT_QK_ISSUE(c_, A_, B_) do { _Pragma("unroll") for (int i_ = 0; i_ < 2; ++i_) { const int d0 = 2 * (c_) + i_; \
        const int off = koff[d0]; \
        if (d0 < 8) { A_[i_] = lds_rd128<0>(K_a + off); B_[i_] = lds_rd128<32 * 256>(K_a + off); } else { A_[i_] = lds_rd128<0>(K_a + off); B_[i_] = lds_rd128<32 * 128>(K_a + off); } } } while (0)
#define ATT_QK_STEP(c_, A_, B_) do { if ((c_) + 1 < NC) asm volatile("s_waitcnt lgkmcnt(4)" : "+v"(A_[0]), "+v"(B_[0]), "+v"(A_[1]), "+v"(B_[1]) :: "memory"); \
        else asm volatile("s_waitcnt lgkmcnt(0)" : "+v"(A_[0]), "+v"(B_[0]), "+v"(A_[1]), "+v"(B_[1]) :: "memory"); \
        __builtin_amdgcn_sched_barrier(0); \
        p0 = __builtin_amdgcn_mfma_f32_32x32x16_bf16(A_[0], qr[2 * (c_)], p0, 0, 0, 0); p1 = __builtin_amdgcn_mfma_f32_32x32x16_bf16(B_[0], qr[2 * (c_)], p1, 0, 0, 0); \
        p0 = __builtin_amdgcn_mfma_f32_32x32x16_bf16(A_[1], qr[2 * (c_) + 1], p0, 0, 0, 0); p1 = __builtin_amdgcn_mfma_f32_32x32x16_bf16(B_[1], qr[2 * (c_) + 1], p1, 0, 0, 0); \
        __builtin_amdgcn_sched_barrier(0); \
        if ((c_) + 2 < NC) ATT_QK_ISSUE((c_) + 2, A_, B_); } while (0)
                ATT_QK_ISSUE(0, xa, xb); ATT_QK_ISSUE(1, ya, yb);
                ATT_QK_STEP(0, xa, xb); ATT_QK_STEP(1, ya, yb); ATT_QK_STEP(2, xa, xb); ATT_QK_STEP(3, ya, yb);
                if constexpr (NC > 4) { ATT_QK_STEP(4, xa, xb); ATT_QK_STEP(5, ya, yb); }
#undef ATT_QK_ISSUE
#undef ATT_QK_STEP
            }
        }
        if (grp == 1) asm volatile("s_waitcnt vmcnt(0)" ::: "memory");
        ATT_BAR();
        if (grp == 1) { if (t + 2 < nt0) ATT_DMAK(t + 2); if (t + 1 < nt0) ATT_DMAV(t + 1); }
        else if (MODE == 0 && t >= 1) {
            unsigned fw[8];
#pragma unroll
            for (int w = 0; w < 8; ++w) fw[w] = lds_rd32u(fl_a + (((t - 1) & 1) * 8 + w) * 4);
            asm volatile("s_waitcnt lgkmcnt(0)" : "+v"(fw[0]), "+v"(fw[1]), "+v"(fw[2]), "+v"(fw[3]), "+v"(fw[4]), "+v"(fw[5]), "+v"(fw[6]), "+v"(fw[7]) :: "memory");
            unsigned alld = 1u;
#pragma unroll
            for (int w = 0; w < 8; ++w) alld &= fw[w];
            if (__builtin_amdgcn_readfirstlane(alld) && t < nt) nt = t;
        }
        if (t < nt) {
        if (actQ) {
            const int k0 = ATT_TILE(t);
            const bool need_mask = (MODE != 2) && (k0 + 63 >= a.q0 + a.wave * 32);
            const int lim = qpos - (k0 + 32 * hi) + (MODE == 1 ? 1 : 0);
            if (MODE == 0) {
#pragma unroll
                for (int r = 0; r < 16; ++r) { p0[r] = __builtin_amdgcn_exp2f(p0[r]); p1[r] = __builtin_amdgcn_exp2f(p1[r]); }
                add1_16(p0); add1_16(p1);
                if (need_mask) {
#pragma unroll
                    for (int r = 0; r < 16; ++r) { p0[r] = (r < lim) ? p0[r] : 1.0f; p1[r] = (r + 16 < lim) ? p1[r] : 1.0f; }
                }
                cumprod_hi(p1, p0); cumprod_lo(p1, p0);
                const float run1 = p1[0], run0 = p0[0];
                const float run = run1 * run0;
                const auto rr = __builtin_amdgcn_permlane32_swap(__float_as_uint(run), __float_as_uint(run), false, false);
                const float tlo = __uint_as_float(rr[0]), thi = __uint_as_float(rr[1]);
                const float seed1 = carryP * (hi ? 1.0f : thi), seed0 = seed1 * run1;
                float sprev = __builtin_amdgcn_rcpf(seed1);
#pragma unroll
                for (int r = 0; r < 16; ++r) p1[r] = __builtin_amdgcn_rcpf(p1[r] * seed1);
                diff16(p1, sprev);
#pragma unroll
                for (int r = 0; r < 16; ++r) p0[r] = __builtin_amdgcn_rcpf(p0[r] * seed0);
                diff16(p0, sprev);
                carryP *= tlo * thi;
            } else {
                if (need_mask) {
#pragma unroll
                    for (int r = 0; r < 16; ++r) { p0[r] = (r < lim) ? p0[r] : -1e30f; p1[r] = (r + 16 < lim) ? p1[r] : -1e30f; }
                }
                float pmax = p0[0];
#pragma unroll
                for (int r = 1; r < 16; ++r) pmax = fmaxf(pmax, p0[r]);
#pragma unroll
                for (int r = 0; r < 16; ++r) pmax = fmaxf(pmax, p1[r]);
                { const auto rr = __builtin_amdgcn_permlane32_swap(__float_as_uint(pmax), __float_as_uint(pmax), false, false);
                  pmax = fmaxf(__uint_as_float(rr[0]), __uint_as_float(rr[1])); }
                if (t == 0) {
#pragma unroll
                    for (int r = 0; r < 16; ++r) { p0[r] -= pmax; p1[r] -= pmax; nb[r] = -pmax; }
                } else if (!__all(pmax <= THRS)) {
                    const float dm = fmaxf(pmax, 0.f);
                    const float alpha = __builtin_amdgcn_exp2f(-dm);
                    l_reg *= alpha;
#pragma unroll
                    for (int d = 0; d < 4; ++d)
#pragma unroll
                        for (int r = 0; r < 16; ++r) o[d][r] *= alpha;
#pragma unroll
                    for (int r = 0; r < 16; ++r) { p0[r] -= dm; p1[r] -= dm; nb[r] -= dm; }
                }
#pragma unroll
                for (int r = 0; r < 16; ++r) { p0[r] = __builtin_amdgcn_exp2f(p0[r]); p1[r] = __builtin_amdgcn_exp2f(p1[r]); }
                float ps = sum16(p0) + sum16(p1);
                { const auto rr = __builtin_amdgcn_permlane32_swap(__float_as_uint(ps), __float_as_uint(ps), false, false);
                  ps = __uint_as_float(rr[0]) + __uint_as_float(rr[1]); }
                l_reg += ps;
            }
            { unsigned w_[16];
#pragma unroll
              for (int i = 0; i < 8; ++i) { w_[i] = cvt_pk_bf16(p0[2 * i], p0[2 * i + 1]); w_[8 + i] = cvt_pk_bf16(p1[2 * i], p1[2 * i + 1]); }
#pragma unroll
              for (int i = 0; i < 16; ++i) p0[i] = __uint_as_float(w_[i]); }
        }
            actP = actQ;
            if (MODE == 0) { const bool dn = __all(carryP > 1e30f); if (lane == 0) lds_wr32u(fl_a + ((t & 1) * 8 + wid) * 4, dn ? 1u : 0u); }
        }
        if (grp == 0) asm volatile("s_waitcnt vmcnt(0)" ::: "memory");
        ATT_BAR();
    }
    if (grp == 0) ATT_BAR();
    asm volatile("s_waitcnt vmcnt(0)" ::: "memory");
#undef ATT_TILE
#undef ATT_DMA
#undef ATT_DMAK
#undef ATT_DMAV
    int tz = MY_TID(a.wave); asm volatile("" : "+v"(tz));
    const int wid2 = tz >> 6, r32b = tz & 31, hib = (tz >> 5) & 1;
    const float rl = (MODE != 0) ? __builtin_amdgcn_rcpf(l_reg) : 1.0f;
    bf16_t* Ow = a.O + (size_t)(wid2 * 32 + r32b) * a.ldo + 8 * hib;
#pragma unroll
    for (int d0 = 0; d0 < 4; ++d0)
#pragma unroll
        for (int k = 0; k < 2; ++k) {
            unsigned ax = cvt_pk_bf16(o[d0][8 * k + 0] * rl, o[d0][8 * k + 1] * rl), ay = cvt_pk_bf16(o[d0][8 * k + 2] * rl, o[d0][8 * k + 3] * rl);
            unsigned bx = cvt_pk_bf16(o[d0][8 * k + 4] * rl, o[d0][8 * k + 5] * rl), by = cvt_pk_bf16(o[d0][8 * k + 6] * rl, o[d0][8 * k + 7] * rl);
            const auto rx = __builtin_amdgcn_permlane32_swap(ax, bx, false, false); const auto ry = __builtin_amdgcn_permlane32_swap(ay, by, false, false);
            const u32x4 w = {rx[0], ry[0], rx[1], ry[1]};
            *(u32x4*)(Ow + d0 * 32 + 16 * k) = w;
        }
}
}

#define XB_TMO      128
#define XB_XCNT(j)  (256  + 64 * (j))
#define XB_XSUB(j)  (1280 + 64 * (j))
#define XB_XGEN(j)  (2304 + 64 * (j))
#define XB_TOP      3328
#define XB_TOPGEN   3392
#define XCD_BAR_WORDS 3456
#define XB_SPIN_CAP (1u << 22)
__device__ __forceinline__ unsigned xb_ld(unsigned* p)              { return __hip_atomic_load(p, __ATOMIC_RELAXED, __HIP_MEMORY_SCOPE_AGENT); }
__device__ __forceinline__ unsigned xb_add(unsigned* p, unsigned v) { return __hip_atomic_fetch_add(p, v, __ATOMIC_RELAXED, __HIP_MEMORY_SCOPE_AGENT); }
__device__ __forceinline__ unsigned xb_xcc_id() { return (unsigned)__builtin_amdgcn_s_getreg((3 << 11) | 20) & 0xFu; }
#define XB_SPIN(cond, bar) do { unsigned _sp = 0; while (cond) { __builtin_amdgcn_s_sleep(1); \
    if ((++_sp & 255u) == 0u) { if (xb_ld(&(bar)[XB_TMO])) break; if (_sp > XB_SPIN_CAP) { atomicAdd(&(bar)[XB_TMO], 1u); break; } } } } while (0)
struct XcdBarrier { unsigned* bar; unsigned x; volatile LAS unsigned* st; int wave; };
__device__ __forceinline__ XcdBarrier xcd_barrier_post(unsigned* bar, volatile LAS unsigned* st, int wave) {
    XcdBarrier b; b.bar = bar; b.x = xb_xcc_id(); b.st = st; b.wave = wave;
    if (MY_TID(wave) == 0) (void)xb_add(&bar[XB_XCNT(b.x)], 1u);
    return b;
}
__device__ __forceinline__ void xcd_barrier_complete(unsigned* bar, unsigned x, unsigned& nloc, unsigned& nx) {
    const unsigned G = gridDim.x * gridDim.y * gridDim.z;
    unsigned sum, cnt, mine, sp = 0u;
    for (;;) {
        sum = 0u; cnt = 0u; mine = 0u;
#pragma unroll
        for (unsigned j = 0; j < 16; ++j) { const unsigned c = xb_ld(&bar[XB_XCNT(j)]); sum += c; cnt += (c > 0u) ? 1u : 0u; mine = (j == x) ? c : mine; }
        if (sum == G) break;
        __builtin_amdgcn_s_sleep(1);
        if ((++sp & 255u) == 0u) { if (xb_ld(&bar[XB_TMO])) break; if (sp > XB_SPIN_CAP) { atomicAdd(&bar[XB_TMO], 1u); break; } }
    }
    nloc = mine > 0u ? mine : 1u; nx = cnt > 0u ? cnt : 1u;
}
__device__ __forceinline__ void xcd_barrier(const XcdBarrier& b) {
    asm volatile("s_waitcnt vmcnt(0)" ::: "memory");
    __syncthreads();
    if (MY_TID(b.wave) == 0) {
        unsigned* bar = b.bar;
        __builtin_amdgcn_s_waitcnt(0);
        unsigned nloc = b.st[0], nx = b.st[1];
        if (nloc == 0u) { xcd_barrier_complete(bar, b.x, nloc, nx); b.st[0] = nloc; b.st[1] = nx; }
        const unsigned old = xb_add(&bar[XB_XSUB(b.x)], 1u);
        const unsigned gen = old / nloc;
        if (old + 1u == (gen + 1u) * nloc) {
            __builtin_amdgcn_fence(__ATOMIC_RELEASE, "agent");
            asm volatile("s_waitcnt vmcnt(0)" ::: "memory");
            const unsigned og = xb_add(&bar[XB_TOP], 1u);
            const unsigned tg = og / nx;
            if (og + 1u == (tg + 1u) * nx) xb_add(&bar[XB_TOPGEN], 1u);
            else XB_SPIN(xb_ld(&bar[XB_TOPGEN]) == tg, bar);
            __builtin_amdgcn_fence(__ATOMIC_ACQUIRE, "agent");
            xb_add(&bar[XB_XGEN(b.x)], 1u);
            asm volatile("s_waitcnt vmcnt(0)" ::: "memory");
        } else {
            XB_SPIN(xb_ld(&bar[XB_XGEN(b.x)]) == gen, bar);
            __builtin_amdgcn_fence(__ATOMIC_ACQUIRE, "agent");
            asm volatile("s_waitcnt vmcnt(0)" ::: "memory");
        }
    }
    __syncthreads();
}

enum { MAP_ID = 0, MAP_GU = 1, MAP_DKV = 2, MAP_UQ = 3 };
struct CvtJob { int in_idx; int ldw; int K; int gain_idx; int gain_off; int dst_row0; int nrows; int map; long src_off; long dst_off; };
constexpr int NJOBS = 24;
__device__ const CvtJob JOBS[NJOBS] = {
    {5, 5120, 2048, 3, 0, 0, 5120, MAP_ID, 0L, (long)W_AIN},
    {5, 5120, 2048, 3, 2048, 0, 5120, MAP_ID, 2048L * 5120, (long)(W_AIN + (size_t)5120 * 2048 * 2)},
    {6, 2048, 2048, -1, 0, 0, 2048, MAP_ID, 0L, (long)W_AOUT},
    {6, 2048, 2048, -1, 0, 0, 2048, MAP_ID, 2048L * 2048, (long)(W_AOUT + (size_t)2048 * 2048 * 2)},
    {7, 1024, 2048, 3, 4096, 0, 1024, MAP_ID, 0L, (long)W_BIN},
    {7, 1024, 2048, 3, 6144, 0, 1024, MAP_ID, 2048L * 1024, (long)(W_BIN + (size_t)1792 * 2048 * 2)},
    {14, 576, 2048, 13, 0, 1024, 768, MAP_DKV, 0L, (long)W_BIN},
    {9, 2304, 512, 8, 0, 0, 2304, MAP_UQ, 0L, (long)W_UQ},
    {9, 2304, 512, 8, 512, 0, 2304, MAP_UQ, 512L * 2304, (long)(W_UQ + (size_t)2304 * 512 * 2)},
    {10, 2048, 2048, -1, 0, 0, 2048, MAP_ID, 0L, (long)W_BOUT},
    {10, 2048, 2048, -1, 0, 0, 2048, MAP_ID, 2048L * 2048, (long)(W_BOUT + (size_t)2048 * 2048 * 2)},
    {12, 1024, 2048, -1, 0, 0, 1024, MAP_ID, 0L, (long)W_MEMKV},
    {12, 1024, 2048, -1, 0, 1024, 1024, MAP_ID, 2048L * 1024, (long)W_MEMKV},
    {12, 1024, 2048, -1, 0, 2048, 1024, MAP_ID, 2L * 2048 * 1024, (long)W_MEMKV},
    {12, 1024, 2048, -1, 0, 3072, 1024, MAP_ID, 3L * 2048 * 1024, (long)W_MEMKV},
    {16, 3072, 512, 15, 0, 0, 3072, MAP_ID, 0L, (long)W_UKV},
    {17, 11264, 2048, 4, 0, 0, 11264, MAP_GU, 0L, (long)W_GU},
    {17, 11264, 2048, 4, 2048, 0, 11264, MAP_GU, 2048L * 11264, (long)(W_GU + (size_t)11264 * 2048 * 2)},
    {17, 11264, 2048, 4, 4096, 0, 11264, MAP_GU, 2L * 2048 * 11264, (long)(W_GU + (size_t)2 * 11264 * 2048 * 2)},
    {17, 11264, 2048, 4, 6144, 0, 11264, MAP_GU, 3L * 2048 * 11264, (long)(W_GU + (size_t)3 * 11264 * 2048 * 2)},
    {18, 2048, 5632, -1, 0, 0, 2048, MAP_ID, 0L, (long)W_DN},
    {18, 2048, 5632, -1, 0, 0, 2048, MAP_ID, 5632L * 2048, (long)(W_DN + (size_t)2048 * 5632 * 2)},
    {18, 2048, 5632, -1, 0, 0, 2048, MAP_ID, 2L * 5632 * 2048, (long)(W_DN + (size_t)2 * 2048 * 5632 * 2)},
    {18, 2048, 5632, -1, 0, 0, 2048, MAP_ID, 3L * 5632 * 2048, (long)(W_DN + (size_t)3 * 2048 * 5632 * 2)},
};
__device__ __forceinline__ int ropeperm(int p) { const int t = p >> 3, e = p & 7; return (e < 4) ? 4 * t + e : 32 + 4 * t + (e - 4); }
__device__ __forceinline__ int map_col(int map, int nr) {
    if (map == MAP_ID) return nr;
    if (map == MAP_GU) { const int tile = nr >> 8, j = nr & 255; return (j < 128) ? 128 * tile + j : FFN + 128 * tile + (j - 128); }
    if (map == MAP_DKV) { return (nr < 512) ? nr : ((nr < 576) ? 512 + ropeperm(nr - 512) : -1); }
    const int head = nr / 192, o = nr - head * 192; return (o < 128) ? nr : head * 192 + 128 + ropeperm(o - 128);
}

struct KArgs { const void* in[20]; float* out; unsigned char* ws; int ph_lo, ph_hi; };

__device__ __forceinline__ void cvt_load(const KArgs& A, const CvtJob& J, int item, int lane, f32x4 (&v)[8]) {
    const int nblk = J.nrows / 32, kb = item / nblk, nb = item - kb * nblk, k0 = 64 * kb, n0 = 32 * nb;
    const float* W = (const float*)A.in[J.in_idx] + J.src_off;
    const int col = map_col(J.map, n0 + 4 * (lane & 7));
    const float* wp = W + (size_t)(k0 + (lane >> 3)) * J.ldw + (col >= 0 ? col : 0);
#pragma unroll
    for (int i = 0; i < 8; ++i) v[i] = __builtin_nontemporal_load((const f32x4*)(wp + (size_t)(8 * i) * J.ldw));
}
__device__ __forceinline__ void cvt_store(const KArgs& A, const CvtJob& J, int item, LAS float* scr, int lane, const f32x4 (&v)[8]) {
    const int nblk = J.nrows / 32, kb = item / nblk, nb = item - kb * nblk, k0 = 64 * kb, n0 = 32 * nb;
    const int col = map_col(J.map, n0 + 4 * (lane & 7));
    const int c = lane & 7;
    f32x4 g0 = (f32x4){1.f, 1.f, 1.f, 1.f}, g1 = g0;
    if (J.gain_idx >= 0) { const float* gain = (const float*)A.in[J.gain_idx] + J.gain_off + k0 + 8 * c; g0 = *(const f32x4*)gain; g1 = *(const f32x4*)(gain + 4); }
#pragma unroll
    for (int i = 0; i < 8; ++i)
#pragma unroll
        for (int e = 0; e < 4; ++e) scr[(8 * i + (lane >> 3)) * 33 + 4 * c + e] = (col >= 0) ? v[i][e] : 0.f;
    asm volatile("s_waitcnt lgkmcnt(0)" ::: "memory");
    bf16_t* dst = (bf16_t*)(A.ws + J.dst_off);
#pragma unroll
    for (int j = 0; j < 4; ++j) { const int n = (lane >> 3) + 8 * j; const LAS float* s = scr + (8 * c) * 33 + n;
        u32x4 o; o.x = pk2(s[0 * 33] * g0[0], s[1 * 33] * g0[1]); o.y = pk2(s[2 * 33] * g0[2], s[3 * 33] * g0[3]); o.z = pk2(s[4 * 33] * g1[0], s[5 * 33] * g1[1]); o.w = pk2(s[6 * 33] * g1[2], s[7 * 33] * g1[3]);
        *(u32x4*)(dst + (size_t)(J.dst_row0 + n0 + n) * J.K + k0 + 8 * c) = o; }
    asm volatile("s_waitcnt lgkmcnt(0)" ::: "memory");
}
__device__ __forceinline__ bool cvt_locate(int g, int& jb, int& local) {
    int b = 0;
    for (jb = 0; jb < NJOBS; ++jb) { const int n = (JOBS[jb].nrows / 32) * (JOBS[jb].K / 64); if (g < b + n) { local = g - b; return true; } b += n; }
    return false;
}

struct Ctx { LAS unsigned char* lds; unsigned char* ws; float* out; const float* x; int G, bx, vcu, lo, hi, wave; XcdBarrier bar; };
#define IN(k) (lo <= (k) && (k) < hi)
#define SEAM(k) do { if ((k) + 1 < hi) xcd_barrier(bar); } while (0)
template <int L>
__device__ __forceinline__ void layer_phases(const Ctx& c) {
    LAS unsigned char* lds = c.lds; unsigned char* ws = c.ws; float* out = c.out; const float* x = c.x;
    const int G = c.G, bx = c.bx, vcu = c.vcu, lo = c.lo, hi = c.hi, wave = c.wave; const XcdBarrier bar = c.bar;
    float* SS = (float*)(ws + WS_SS); float* SSQ = (float*)(ws + WS_SSQ); float* SSL = (float*)(ws + WS_SSL);
    float* COS = (float*)(ws + WS_COS); float* SIN = (float*)(ws + WS_SIN);
    bf16_t* HB = (bf16_t*)(ws + WS_HB); bf16_t* KV = (bf16_t*)(ws + WS_KV); bf16_t* KR = (bf16_t*)(ws + WS_KR);
    bf16_t* MEMKV = (bf16_t*)(ws + WS_MEMKV); bf16_t* MEMN = (bf16_t*)(ws + WS_MEMN);
    bf16_t* PROJ = (bf16_t*)(ws + WS_PROJ); bf16_t* PB = (bf16_t*)(ws + WS_PB); bf16_t* QB = (bf16_t*)(ws + WS_Q);
    bf16_t* MIX = (bf16_t*)(ws + WS_MIX); bf16_t* HID = (bf16_t*)(ws + WS_HID);
    {
        constexpr int pb = 1 + 6 * L; constexpr bool isA = L < 2; constexpr int li = L & 1;
        if (IN(pb)) {
            if (L == 0) {
                pg8::Gemm g{MEMN, (const bf16_t*)(ws + W_MEMKV), MROWS, 4096, 2048, 2048, 2048}; pg8::StaticOrder S; S.init(MROWS, 4096, G, bx);
                EpiScaleBf16<0> E{MEMKV, 4096, nullptr};
                pg8::gemm_phase(lds, g, S, E, wave);
            }
            if (isA) {
                pg8::Gemm g{HB, (const bf16_t*)(ws + W_AIN) + (size_t)li * 5120 * 2048, M, A_IN, 2048, 2048, 2048}; pg8::StaticOrder S; S.init(M, A_IN, G, bx);
                EpiScaleBf16<1> E{PROJ, A_IN, SS};
                if (PROBE_NULL_AIN) { EpiNull E0{SSQ}; pg8::gemm_phase(lds, g, S, E0, wave); }
                pg8::gemm_phase(lds, g, S, E, wave);
            } else {
                const int N = (L == 2) ? 1792 : 1024;
                pg8::Gemm g{HB, (const bf16_t*)(ws + W_BIN) + (size_t)li * 1792 * 2048, M, N, 2048, 2048, 2048}; pg8::StaticOrder S; S.init(M, N, G, bx);
                EpiBIn E{PB, KR, SS, SSQ, SSL, COS, SIN};
                pg8::gemm_phase(lds, g, S, E, wave);
            }
            SEAM(pb);
        }
        if (!isA && IN(pb + 1)) {
            { pg8::Gemm g{PB, (const bf16_t*)(ws + W_UQ) + (size_t)li * 2304 * 512, M, UQ_N, 512, PB_LD, 512}; pg8::StaticOrder S; S.init(M, UQ_N, G, bx);
              EpiUq E{QB, SSQ, COS, SIN};
              pg8::gemm_phase(lds, g, S, E, wave); }
            if (L == 2) {
                pg8::Gemm g{PB + 1024, (const bf16_t*)(ws + W_UKV), M, UKV_N, 512, PB_LD, 512}; pg8::StaticOrder S; S.init(M, UKV_N, G, bx);
                EpiScaleBf16<2> E{KV, KVLD, SSL};
                pg8::gemm_phase(lds, g, S, E, wave);
            }
            SEAM(pb + 1);
        }
        if (IN(pb + 2)) {
          for (int rep = 0; rep < PROBE_ATT; ++rep) {
            for (int rep2 = 0; rep2 < PROBE_ATT_MAIN; ++rep2)
            for (int p = vcu; p < BATCH * NH * 4; p += G) {
                const int xx = p & 3, bh = p >> 2, b = bh / NH, h = bh - b * NH;
                for (int half = 0; half < 2; ++half) {
                    const int xq = half ? (7 - xx) : xx;
                    const size_t tok0 = (size_t)b * SEQ, tq = tok0 + (size_t)xq * 256;
                    if (isA) {
                        att::Args a{PROJ + tq * A_IN + h * 128, A_IN, PROJ + tok0 * A_IN + 1536 + h * 128, A_IN, nullptr, 0,
                                    PROJ + tok0 * A_IN + 3072 + h * 128, A_IN, MIX + tq * DM + h * 128, DM, xq * 256, 4 * (xq + 1), wave};
                        att::attn_unit<0, 128>(lds, a);
                    } else {
                        att::Args a{QB + tq * UQ_N + h * 192, UQ_N, KV + tok0 * KVLD + h * 256, KVLD, KR + tok0 * 64, 64,
                                    KV + tok0 * KVLD + h * 256 + 128, KVLD, MIX + tq * DM + h * 128, DM, xq * 256, 4 * (xq + 1), wave};
                        att::attn_unit<1, 192>(lds, a);
                    }
                }
            }
            for (int rep2 = 0; rep2 < PROBE_ATT_MEM; ++rep2)
            for (int p = vcu; p < BATCH * MEMH * 8; p += G) {
                const int xq = p & 7, bh = p >> 3, b = bh >> 2, h = bh & 3;
                const size_t tq = (size_t)b * SEQ + (size_t)xq * 256;
                const bf16_t* Qp = isA ? (PROJ + tq * A_IN + 4608 + h * 128) : (PB + tq * PB_LD + 512 + h * 128);
                const bf16_t* Kp = MEMKV + (size_t)(b * MEML) * 4096 + L * 1024 + h * 128;
                att::Args a{Qp, isA ? A_IN : PB_LD, Kp, 4096, nullptr, 0, Kp + 512, 4096, MIX + tq * DM + 1536 + h * 128, DM, 0, 4, wave};
                att::attn_unit<2, 128>(lds, a);
            }
            __syncthreads();
          }
            SEAM(pb + 2);
        }
        if (IN(pb + 3)) {
            const bf16_t* Wt = (const bf16_t*)(ws + (isA ? W_AOUT : W_BOUT)) + (size_t)li * 2048 * 2048;
            pg8::Gemm g{MIX, Wt, M, DM, 2048, 2048, 2048}; pg8::StaticOrder S; S.init(M, DM, G, bx);
            if (PROBE_NULL_OUT) { EpiNull E0{SSQ}; pg8::gemm_phase(lds, g, S, E0, wave); }
            EpiResid<false, false> E{x, out, HB, SS, (LAS float*)(lds + LDSCTL_OFF + 2048)};
            pg8::gemm_phase(lds, g, S, E, wave);
            SEAM(pb + 3);
        }
        if (IN(pb + 4)) {
            pg8::Gemm g{HB, (const bf16_t*)(ws + W_GU) + (size_t)L * 11264 * 2048, M, 2 * FFN, 2048, 2048, 2048}; pg8::StaticOrder S; S.init(M, 2 * FFN, G, bx);
#if PROBE_SPLIT_GU
            { pg8::Gemm g1 = g; g1.N = FFN; pg8::StaticOrder S1; S1.init(M, FFN, G, bx); EpiSwiglu E1{HID, SS, 0};
              pg8::gemm_phase(lds, g1, S1, E1, wave);
              xcd_barrier(bar);
              pg8::Gemm g2 = g1; g2.Bt = g.Bt + (size_t)FFN * 2048; EpiSwiglu E2{HID, SS, FFN / 2};
              pg8::gemm_phase(lds, g2, S1, E2, wave); }
#else
            EpiSwiglu E{HID, SS, 0};
            pg8::gemm_phase(lds, g, S, E, wave);
            if (PROBE_GU > 1) pg8::gemm_phase(lds, g, S, E, wave);
#endif
            SEAM(pb + 4);
        }
        if (IN(pb + 5)) {
            pg8::Gemm g{HID, (const bf16_t*)(ws + W_DN) + (size_t)L * 2048 * 5632, M, DM, FFN, FFN, FFN}; pg8::StaticOrder S; S.init(M, DM, G, bx);
            if (PROBE_NULL_DN) { EpiNull E0{SSQ}; pg8::gemm_phase(lds, g, S, E0, wave); }
            EpiResid<false, false> E{x, out, HB, SS, (LAS float*)(lds + LDSCTL_OFF + 2048)};
            pg8::gemm_phase(lds, g, S, E, wave);
            SEAM(pb + 5);
        }
    }
}
#undef IN
#undef SEAM
__global__ void __launch_bounds__(512, 2) yoco_fwd(KArgs args) {
    extern __shared__ __attribute__((aligned(16))) unsigned char lds_raw[];
    LAS unsigned char* lds = (LAS unsigned char*)lds_raw;
    volatile LAS unsigned* MISC = (volatile LAS unsigned*)(lds + MISC_OFF);
    const int wave = __builtin_amdgcn_readfirstlane((int)threadIdx.x >> 6);
    const int tid = MY_TID(wave), lane = tid & 63;
    const int G = gridDim.x, bx = blockIdx.x;
    const int vcu = (G % 8 == 0) ? (bx % 8) * (G / 8) + bx / 8 : bx;
    unsigned char* ws = args.ws;
    unsigned* ctl = (unsigned*)(ws + WS_CTL);
    for (int u = tid; u < (LDS_BYTES - LDSCTL_OFF) / 4; u += 512) ((LAS unsigned*)(lds + LDSCTL_OFF))[u] = 0u;
    __syncthreads();
    const int lo = args.ph_lo, hi = args.ph_hi;
    XcdBarrier bar; bar.bar = ctl + CW_BAR; bar.x = 0; bar.st = MISC + 8; bar.wave = wave;
    if (hi - lo > 1) bar = xcd_barrier_post(ctl + CW_BAR, MISC + 8, wave);
#define IN(k) (lo <= (k) && (k) < hi)
#define SEAM(k) do { if ((k) + 1 < hi) xcd_barrier(bar); } while (0)

    const float* x = (const float*)args.in[0];
    float* out = args.out;
    float* SS = (float*)(ws + WS_SS); float* SSQ = (float*)(ws + WS_SSQ); float* SSL = (float*)(ws + WS_SSL);
    float* COS = (float*)(ws + WS_COS); float* SIN = (float*)(ws + WS_SIN);
    bf16_t* HB = (bf16_t*)(ws + WS_HB); bf16_t* KV = (bf16_t*)(ws + WS_KV); bf16_t* KR = (bf16_t*)(ws + WS_KR);
    bf16_t* MEMKV = (bf16_t*)(ws + WS_MEMKV); bf16_t* MEMN = (bf16_t*)(ws + WS_MEMN);
    bf16_t* PROJ = (bf16_t*)(ws + WS_PROJ); bf16_t* PB = (bf16_t*)(ws + WS_PB); bf16_t* QB = (bf16_t*)(ws + WS_Q);
    bf16_t* MIX = (bf16_t*)(ws + WS_MIX); bf16_t* HID = (bf16_t*)(ws + WS_HID);
    const int gw = vcu * 8 + wave, NGW = G * 8;

    if (IN(0)) {
      for (int rep = 0; rep < PROBE_PRO; ++rep) {
        LAS float* scr = (LAS float*)(lds + wave * 16384);
        { f32x4 va[8], vb[8]; int ja = 0, la = 0, jbn = 0, lb = 0;
          int gi = gw; bool ha = cvt_locate(gi, ja, la);
          if (ha) cvt_load(args, JOBS[ja], la, lane, va);
          while (ha) {
              const bool hb = cvt_locate(gi + NGW, jbn, lb);
              if (hb) cvt_load(args, JOBS[jbn], lb, lane, vb);
              cvt_store(args, JOBS[ja], la, scr, lane, va);
              if (!hb) break;
              gi += 2 * NGW; ha = cvt_locate(gi, ja, la);
              if (ha) cvt_load(args, JOBS[ja], la, lane, va);
              cvt_store(args, JOBS[jbn], lb, scr, lane, vb);
          } }
        { f32x4 va[8], vb[8];
          auto ldrow = [&](f32x4 (&v)[8], int m) { const f32x4* xr = (const f32x4*)(x + (size_t)m * DM) + lane;
#pragma unroll
              for (int j = 0; j < 8; ++j) v[j] = __builtin_nontemporal_load(xr + 64 * j); };
          auto strow = [&](const f32x4 (&v)[8], int m) { float s = 0.f;
#pragma unroll
              for (int j = 0; j < 8; ++j) s += sq4(v[j]);
              s = wave_sum(s);
              u32x2* o8 = (u32x2*)(HB + (size_t)m * DM) + lane;
#pragma unroll
              for (int j = 0; j < 8; ++j) { u32x2 w; w.x = pk2(v[j][0], v[j][1]); w.y = pk2(v[j][2], v[j][3]); o8[64 * j] = w; }
              if (lane < 8) SS[(size_t)m * 8 + lane] = (lane == 0) ? s : 0.f; };
          int m = gw; if (m < M) ldrow(va, m);
          while (m < M) {
              const int mn = m + NGW; if (mn < M) ldrow(vb, mn);
              strow(va, m);
              if (mn >= M) break;
              m = mn + NGW; if (m < M) ldrow(va, m);
              strow(vb, mn);
          } }
        { const float* mem = (const float*)args.in[1]; const float* mg = (const float*)args.in[11];
          for (int m = gw; m < MROWS; m += NGW) {
            const f32x4* xr = (const f32x4*)(mem + (size_t)m * DM) + lane; const f32x4* gr = (const f32x4*)mg + lane;
            f32x4 v[8]; float s = 0.f;
#pragma unroll
            for (int j = 0; j < 8; ++j) { v[j] = __builtin_nontemporal_load(xr + 64 * j); s += sq4(v[j]); }
            s = wave_sum(s); const float rstd = rsq(s * (1.0f / 2048.0f) + RMS_EPS);
            u32x2* o8 = (u32x2*)(MEMN + (size_t)m * DM) + lane;
#pragma unroll
            for (int j = 0; j < 8; ++j) { const f32x4 gg = gr[64 * j]; const f32x4 y = v[j] * rstd * gg; u32x2 w; w.x = pk2(y[0], y[1]); w.y = pk2(y[2], y[3]); o8[64 * j] = w; }
          } }
        { const int* pos = (const int*)args.in[2];
          for (int idx = (vcu * 512 + tid); idx < M * 32; idx += G * 512) {
            const int tok = idx >> 5, i = idx & 31;
            const float inv_freq = __builtin_amdgcn_exp2f((float)i * (-13.287712379549449f / 32.0f));
            const float ang = (float)pos[tok] * inv_freq;
            const double rev = (double)ang * 0.15915494309189535;
            const float fr_ = (float)(rev - floor(rev));
            COS[idx] = __builtin_amdgcn_cosf(fr_); SIN[idx] = __builtin_amdgcn_sinf(fr_);
          } }
      }
        SEAM(0);
    }

    { Ctx c{lds, ws, out, x, G, bx, vcu, lo, hi, wave, bar};
      layer_phases<0>(c); layer_phases<1>(c); layer_phases<2>(c); layer_phases<3>(c); }
    if (IN(25)) {
        const float* fg = (const float*)args.in[19];
        int tz = MY_TID(wave); asm volatile("" : "+v"(tz));
        const int lane = tz & 63, gw = vcu * 8 + (tz >> 6);
        { u32x2 wa[8], wb[8]; float sa = 0.f, sb = 0.f;
          auto ldrow = [&](u32x2 (&w)[8], float& s, int m) { s = (lane < 8) ? SS[(size_t)m * 8 + lane] : 0.f;
              const u32x2* hr = (const u32x2*)((const bf16_t*)(ws + WS_HB) + (size_t)m * DM) + lane;
#pragma unroll
              for (int j = 0; j < 8; ++j) w[j] = hr[64 * j]; };
          auto strow = [&](const u32x2 (&w)[8], float s, int m) { s = wave_sum(s); const float rstd = rsq(s * (1.0f / 2048.0f) + RMS_EPS);
              f32x4* xr = (f32x4*)(out + (size_t)m * DM) + lane; const f32x4* gr = (const f32x4*)fg + lane;
#pragma unroll
              for (int j = 0; j < 8; ++j) { const f32x4 v = (f32x4){__uint_as_float(w[j].x << 16), __uint_as_float(w[j].x & 0xffff0000u), __uint_as_float(w[j].y << 16), __uint_as_float(w[j].y & 0xffff0000u)};
                  __builtin_nontemporal_store(v * rstd * gr[64 * j], xr + 64 * j); } };
          int m = gw; if (m < M) ldrow(wa, sa, m);
          while (m < M) {
              const int mn = m + NGW; if (mn < M) ldrow(wb, sb, mn);
              strow(wa, sa, m);
              if (mn >= M) break;
              m = mn + NGW; if (m < M) ldrow(wa, sa, m);
              strow(wb, sb, mn);
          } }
    }
#undef IN
#undef SEAM
}

extern "C" void kernel_launch(void* const* d_in, const int* in_sizes, int n_in, void* d_out, int out_size, void* d_ws, size_t ws_size, hipStream_t stream) {
    static int grid = 0;
    if (grid == 0) {
        if (n_in != 20 || out_size != M * DM || ws_size < WS_END) { fprintf(stderr, "kernel_launch: unexpected shapes (n_in %d out %d ws %zu need %zu)\n", n_in, out_size, ws_size, (size_t)WS_END); grid = -1; return; }
        int dev = 0, cus = 0, per_cu = 0;
        if (hipGetDevice(&dev) != hipSuccess || hipDeviceGetAttribute(&cus, hipDeviceAttributeMultiprocessorCount, dev) != hipSuccess) { grid = -1; return; }
        if (hipFuncSetAttribute((const void*)yoco_fwd, hipFuncAttributeMaxDynamicSharedMemorySize, LDS_BYTES) != hipSuccess) { fprintf(stderr, "kernel_launch: hipFuncSetAttribute failed\n"); grid = -1; return; }
        if (hipOccupancyMaxActiveBlocksPerMultiprocessor(&per_cu, (const void*)yoco_fwd, 512, LDS_BYTES) != hipSuccess || per_cu < 1) { fprintf(stderr, "kernel_launch: occupancy query says %d\n", per_cu); (void)hipGetLastError(); }
        grid = cus;
    }
    if (grid < 0) return;
    (void)hipMemsetAsync((char*)d_ws + WS_CTL, 0, CTL_ZERO_BYTES, stream);
    KArgs a{};
    for (int i = 0; i < 20; ++i) a.in[i] = d_in[i];
    a.out = (float*)d_out; a.ws = (unsigned char*)d_ws;
#if MK_PER_PHASE
    for (int k = 0; k < 26; ++k) {
        if (k >= 1 && k <= 12 && ((k - 1) % 6) == 1) continue;
        a.ph_lo = k; a.ph_hi = k + 1;
        hipLaunchKernelGGL(yoco_fwd, dim3(grid), dim3(512), LDS_BYTES, stream, a);
    }
#else
    a.ph_lo = 0; a.ph_hi = 26;
    hipLaunchKernelGGL(yoco_fwd, dim3(grid), dim3(512), LDS_BYTES, stream, a);
#endif
    const hipError_t le = hipPeekAtLastError();
    if (le != hipSuccess) fprintf(stderr, "kernel_launch: launch failed: %s\n", hipGetErrorName(le));
}
```

```cpp
#include <hip/hip_runtime.h>
#include <cstdio>
#include <cstdint>

#ifndef MK_PER_PHASE
#define MK_PER_PHASE 0
#endif

#ifndef PROBE_ATT
#define PROBE_ATT 1
#endif
#ifndef PROBE_ATT_MAIN
#define PROBE_ATT_MAIN 1
#endif
#ifndef PROBE_ATT_MEM
#define PROBE_ATT_MEM 1
#endif
#ifndef PROBE_GU
#define PROBE_GU 1
#endif
#ifndef PROBE_PRO
#define PROBE_PRO 1
#endif
#ifndef PROBE_EPI
#define PROBE_EPI 1
#endif
#ifndef PROBE_NULL_DN
#define PROBE_NULL_DN 0
#endif
#ifndef PROBE_NULL_OUT
#define PROBE_NULL_OUT 0
#endif
#ifndef PROBE_NULL_AIN
#define PROBE_NULL_AIN 0
#endif
#ifndef PROBE_NULL_B
#define PROBE_NULL_B 0
#endif
#ifndef PROBE_EPI_WHICH
#define PROBE_EPI_WHICH 0
#endif
#ifndef PROBE_SPLIT_GU
#define PROBE_SPLIT_GU 0
#endif
#define LAS __attribute__((address_space(3)))
#define GAS __attribute__((address_space(1)))
typedef unsigned short bf16_t;
typedef short bf16x8 __attribute__((ext_vector_type(8)));
typedef short s16x4 __attribute__((ext_vector_type(4)));
typedef float f32x4 __attribute__((ext_vector_type(4)));
typedef float f32x16 __attribute__((ext_vector_type(16)));
typedef unsigned u32x4 __attribute__((ext_vector_type(4)));
typedef unsigned u32x2 __attribute__((ext_vector_type(2)));

constexpr int BATCH = 16, SEQ = 2048, DM = 2048, M = BATCH * SEQ;
constexpr int NH = 12, HD = 128, MEMH = 4, MEML = 256, MROWS = BATCH * MEML;
constexpr int FFN = 5632;
constexpr int A_IN = 5120, PB_LD = 1792, UQ_N = 2304, UKV_N = 3072, KVLD = 3072;
constexpr float RMS_EPS = 1e-6f;

constexpr size_t MiB = 1u << 20;
constexpr size_t WS_CTL = 0, CTL_ZERO_BYTES = 64 * 1024;
constexpr size_t WS_SS = 1 * MiB;
constexpr size_t WS_SSQ = 5 * MiB;
constexpr size_t WS_SSL = 6 * MiB;
constexpr size_t WS_COS = 7 * MiB;
constexpr size_t WS_SIN = 11 * MiB;
constexpr size_t WS_HB = 16 * MiB;
constexpr size_t WS_KV = 144 * MiB;
constexpr size_t WS_KR = 336 * MiB;
constexpr size_t WS_MEMKV = 340 * MiB;
constexpr size_t WS_MEMN = 372 * MiB;
constexpr size_t WS_BIG = 388 * MiB;
constexpr size_t WS_PROJ = WS_BIG;
constexpr size_t WS_PB = WS_BIG;
constexpr size_t WS_Q = WS_BIG + 112 * MiB;
constexpr size_t WS_MIX = WS_BIG + 320 * MiB;
constexpr size_t WS_HID = WS_BIG;
constexpr size_t WS_W = 836 * MiB;
constexpr size_t W_AIN = WS_W;
constexpr size_t W_AOUT = W_AIN + 40 * MiB;
constexpr size_t W_BIN = W_AOUT + 16 * MiB;
constexpr size_t W_UQ = W_BIN + 14 * MiB;
constexpr size_t W_BOUT = W_UQ + 5 * MiB;
constexpr size_t W_MEMKV = W_BOUT + 16 * MiB;
constexpr size_t W_UKV = W_MEMKV + 16 * MiB;
constexpr size_t W_GU = W_UKV + 3 * MiB;
constexpr size_t W_DN = W_GU + 176 * MiB;
constexpr size_t WS_END = W_DN + 88 * MiB;
static_assert(WS_HID + (size_t)M * FFN * 2 <= WS_W && WS_MIX + (size_t)M * DM * 2 <= WS_W, "ws map");
constexpr int CW_BAR = 4096;

constexpr int RING_BYTES = 131072;
constexpr int LDSCTL_OFF = RING_BYTES, MISC_OFF = LDSCTL_OFF + 320;
constexpr int LDS_BYTES = 147456;

__device__ __forceinline__ unsigned f2bf(float f) { unsigned u = __builtin_bit_cast(unsigned, f); return (u + 0x7fffu + ((u >> 16) & 1u)) >> 16; }
__device__ __forceinline__ unsigned pk2(float lo, float hi) { return f2bf(lo) | (f2bf(hi) << 16); }
__device__ __forceinline__ unsigned cvt_pk_bf16(float lo, float hi) { unsigned r; asm volatile("v_cvt_pk_bf16_f32 %0, %1, %2" : "=v"(r) : "v"(lo), "v"(hi)); return r; }
__device__ __forceinline__ int lane_id() { int l; asm volatile("v_mbcnt_lo_u32_b32 %0, -1, 0\n\tv_mbcnt_hi_u32_b32 %0, -1, %0" : "=v"(l)); return l; }
#define MY_TID(wave_) (((wave_) << 6) | lane_id())
__device__ __forceinline__ float wave_sum(float v) {
#pragma unroll
    for (int o = 1; o < 64; o <<= 1) v += __shfl_xor(v, o);
    return v;
}

namespace pg8 {
constexpr int BM = 256, BK = 64, HALF = 128, HTB = HALF * BK * 2, STAGE_BYTES = 8 * HTB, NXCD = 8, WGM = 4;
__host__ __device__ __forceinline__ int lds_byte(int r, int c) { const int st = (r >> 4) * 2 + (c >> 5), rr = r & 15, cc = c & 31, ob = rr * 64 + cc * 2; return st * 1024 + (ob ^ (((ob >> 9) & 1) << 5)); }
__host__ __device__ __forceinline__ void stage_rc(int b, int& R, int& C) { const int st = b / 1024, sb = b % 1024, swz = sb ^ (((sb >> 9) & 1) << 5); R = (st >> 1) * 16 + swz / 64; C = (st & 1) * 32 + (swz % 64) / 2; }
__host__ __device__ __forceinline__ int perm32(int rho) { const int n = rho >> 4, i = rho & 15; return 8 * (i >> 2) + 4 * n + (i & 3); }

struct Unit { int pm, pn; };
struct Gemm { const bf16_t* A; const bf16_t* Bt; int M, N, K, lda, ldb; };

struct StaticOrder {
    int nM, nN, nwg, G, c;
    struct Pos { int L, gid, rem; };
    __device__ bool step(Pos& p, Unit& u) const {
        p.L += G; if (p.L >= nwg) return false;
        const int nig = WGM * nN; p.rem += G >> 3;
        while (p.rem >= nig) { p.rem -= nig; ++p.gid; }
        u.pm = p.gid * WGM + (p.rem & (WGM - 1)); u.pn = p.rem / WGM; return true;
    }
    __device__ bool first(Pos& p, Unit& u) const {
        p.L = c; if (p.L >= nwg) return false;
        const int wgid = (p.L & 7) * (nwg >> 3) + (p.L >> 3), nig = WGM * nN;
        p.gid = wgid / nig; p.rem = wgid - p.gid * nig;
        u.pm = p.gid * WGM + (p.rem & (WGM - 1)); u.pn = p.rem / WGM; return true;
    }
    __device__ void init(int M_, int N_, int G_, int c_) { nM = M_ / BM; nN = N_ / BM; nwg = nM * nN; G = G_; c = c_; }
    __device__ bool next(int i, Unit& u) const {
        const long L = (long)i * G + c; if (L >= nwg) return false;
        int wgid = (int)L; { const int q = nwg / NXCD, r = nwg % NXCD, xcd = wgid % NXCD, off = wgid / NXCD; wgid = (xcd < r ? xcd * (q + 1) : r * (q + 1) + (xcd - r) * q) + off; }
        const int nig = WGM * nN, gid = wgid / nig, fm = gid * WGM, gsz = (nM - fm) < WGM ? (nM - fm) : WGM;
        u.pm = fm + ((wgid % nig) % gsz); u.pn = (wgid % nig) / gsz; return true;
    }
};

__device__ __forceinline__ const char* uptr(const char* p) {
    const unsigned long long v = (unsigned long long)p;
    const unsigned lo = (unsigned)__builtin_amdgcn_readfirstlane((int)(unsigned)v), hi = (unsigned)__builtin_amdgcn_readfirstlane((int)(unsigned)(v >> 32));
    return (const char*)(((unsigned long long)hi << 32) | lo);
}
template <int OFF> __device__ __forceinline__ f32x4 lds_rd128f(int addr) { f32x4 r; asm volatile("ds_read_b128 %0, %1 offset:%2" : "=&v"(r) : "v"(addr), "i"(OFF) : "memory"); return r; }
template <class Epi>
__device__ __forceinline__ void gemm_phase(LAS unsigned char* lds, const Gemm g, const StaticOrder& S, const Epi& E, const int wave) {
    int tid_ = MY_TID(wave); asm volatile("" : "+v"(tid_));
    const int tid = tid_, wid = __builtin_amdgcn_readfirstlane(tid >> 6), lane = tid & 63, wr = wid >> 2, wc = wid & 3, fr = lane & 15, fq = lane >> 4;
    const int K = g.K, nt = K / BK;
    unsigned voffA[2], voffB[2];
#pragma unroll
    for (int i = 0; i < 2; ++i) { int R, C; stage_rc(tid * 16 + i * 8192, R, C); const int Rb = (R & ~31) + perm32(R & 31);
        voffA[i] = (unsigned)(R * g.lda + C) * 2u; voffB[i] = (unsigned)(Rb * g.ldb + C) * 2u; }
    const size_t kstep = (size_t)(BK * 2);
    const size_t hstepA = (size_t)HALF * g.lda * 2, hstepB = (size_t)HALF * g.ldb * 2;
    const size_t tstepA = 2 * hstepA, tstepB = 2 * hstepB;
    const unsigned ldsw = (unsigned)wid * 1024u;
    const int aoff = lds_byte(wr * 64 + fr, fq * 8), boff = lds_byte(wc * 32 + fr, fq * 8);
#define PG8_SA(b, h) (((b) * 2 + (h)) * HTB)
#define PG8_SB(b, h) ((4 + (b) * 2 + (h)) * HTB)
#define PG8_STAGE(bufoff, gbase, voff) do { const char* gb__ = uptr((const char*)(gbase)); _Pragma("unroll") for (int _i = 0; _i < 2; ++_i) { asm volatile("" : "+v"((voff)[_i])); \
        __builtin_amdgcn_global_load_lds((const unsigned*)(gb__ + (voff)[_i]), (LAS unsigned*)(lds + (bufoff) + ldsw + _i * 8192), 16, 0, 0); } } while (0)
#define PG8_LDA(dst, b, h) do { _Pragma("unroll") for (int m = 0; m < 4; ++m) _Pragma("unroll") for (int k = 0; k < 2; ++k) dst[m][k] = *(const LAS bf16x8*)(lds + PG8_SA(b, h) + aoff + m * 2048 + k * 1024); } while (0)
#define PG8_LDB(dst, b, h) do { _Pragma("unroll") for (int n = 0; n < 2; ++n) _Pragma("unroll") for (int k = 0; k < 2; ++k) dst[n][k] = *(const LAS bf16x8*)(lds + PG8_SB(b, h) + boff + n * 2048 + k * 1024); } while (0)
#define PG8_MMA(ai, bj, At, Bt) do { __builtin_amdgcn_s_setprio(3); _Pragma("unroll") for (int m = 0; m < 4; ++m) _Pragma("unroll") for (int n = 0; n < 2; ++n) _Pragma("unroll") for (int k = 0; k < 2; ++k) \
        acc[ai][bj][m][n] = __builtin_amdgcn_mfma_f32_16x16x32_bf16(Bt[n][k], At[m][k], acc[ai][bj][m][n], 0, 0, 0); __builtin_amdgcn_s_setprio(0); } while (0)
#define PG8_MMAZ(ai, bj, At, Bt) do { __builtin_amdgcn_s_setprio(3); _Pragma("unroll") for (int m = 0; m < 4; ++m) _Pragma("unroll") for (int n = 0; n < 2; ++n) { \
        acc[ai][bj][m][n] = __builtin_amdgcn_mfma_f32_16x16x32_bf16(Bt[n][0], At[m][0], (f32x4){0.f, 0.f, 0.f, 0.f}, 0, 0, 0); \
        acc[ai][bj][m][n] = __builtin_amdgcn_mfma_f32_16x16x32_bf16(Bt[n][1], At[m][1], acc[ai][bj][m][n], 0, 0, 0); } __builtin_amdgcn_s_setprio(0); } while (0)
#define PG8_WAIT_V(n) asm volatile("s_waitcnt vmcnt(" #n ")" ::: "memory")
#define PG8_WAIT_L(n) asm volatile("s_waitcnt lgkmcnt(" #n ")" ::: "memory")
#define PG8_BAR __builtin_amdgcn_s_barrier()
#define PG8_SCHED __builtin_amdgcn_sched_barrier(0)
    Unit cur, nxt; int ui = 0;
    const bool incr = ((S.nwg | S.G) & 7) == 0 && (S.nM % WGM) == 0;
    StaticOrder::Pos pos;
    if (incr) { if (!S.first(pos, cur)) return; } else if (!S.next(0, cur)) return;
    constexpr int RS_LDS = LDSCTL_OFF + 8192;
#define PG8_RS_DMA(pm_) do { if constexpr (Epi::RSTD) { unsigned vo__ = (unsigned)tid * 16u; asm volatile("" : "+v"(vo__)); \
        __builtin_amdgcn_global_load_lds((const unsigned*)((const char*)E.rs_src() + (size_t)(pm_) * 8192 + vo__), (LAS unsigned*)(lds + RS_LDS + ldsw), 16, 0, 0); } } while (0)
    PG8_RS_DMA(cur.pm);
    f32x4 acc[2][2][4][2];
    bf16x8 At[4][2], B0[2][2], B1[2][2];
    const char* cA = (const char*)g.A + (size_t)cur.pm * tstepA; const char* cB = (const char*)g.Bt + (size_t)cur.pn * tstepB;
    PG8_STAGE(PG8_SB(0, 0), cB, voffB); PG8_STAGE(PG8_SB(0, 1), cB + hstepB, voffB); PG8_STAGE(PG8_SA(0, 0), cA, voffA); PG8_STAGE(PG8_SA(0, 1), cA + hstepA, voffA);
    PG8_STAGE(PG8_SB(1, 0), cB + kstep, voffB); PG8_STAGE(PG8_SA(1, 0), cA + kstep, voffA); PG8_STAGE(PG8_SB(1, 1), cB + hstepB + kstep, voffB);
    PG8_WAIT_V(6);
    if (wr == 1) PG8_BAR;
    PG8_BAR;
    for (;;) {
        const bool has_next = incr ? S.step(pos, nxt) : S.next(ui + 1, nxt);
        const char* nA = has_next ? (const char*)g.A + (size_t)nxt.pm * tstepA : cA; const char* nB = has_next ? (const char*)g.Bt + (size_t)nxt.pn * tstepB : cB;
#define PG8_ITER(MMA0_, W12_) do { \
            const bool last = (t == nt - 2); \
            const char* a1 = cA + (size_t)(t + 1) * kstep; \
            const char* a2 = last ? nA : cA + (size_t)(t + 2) * kstep; const char* b2 = last ? nB : cB + (size_t)(t + 2) * kstep; \
            const char* a3 = a2 + kstep; const char* b3 = b2 + kstep; \
            PG8_LDB(B0, 0, 0); PG8_LDB(B1, 0, 1); PG8_SCHED; PG8_LDA(At, 0, 0); PG8_STAGE(PG8_SA(1, 1), a1 + hstepA, voffA); \
            W12_; PG8_WAIT_L(0); PG8_BAR; MMA0_(0, 0, At, B0); MMA0_(0, 1, At, B1); PG8_BAR; PG8_SCHED; \
            PG8_LDA(At, 0, 1); PG8_STAGE(PG8_SB(0, 0), b2, voffB); PG8_STAGE(PG8_SB(0, 1), b2 + hstepB, voffB); PG8_STAGE(PG8_SA(0, 0), a2, voffA); \
            W12_; PG8_WAIT_L(0); PG8_BAR; MMA0_(1, 0, At, B0); MMA0_(1, 1, At, B1); PG8_BAR; PG8_SCHED; \
            PG8_LDB(B0, 1, 0); PG8_LDB(B1, 1, 1); PG8_SCHED; PG8_LDA(At, 1, 0); PG8_STAGE(PG8_SA(0, 1), a2 + hstepA, voffA); \
            PG8_WAIT_V(8); PG8_WAIT_L(0); PG8_BAR; PG8_MMA(0, 0, At, B0); PG8_MMA(0, 1, At, B1); PG8_BAR; PG8_SCHED; \
            PG8_LDA(At, 1, 1); PG8_STAGE(PG8_SB(1, 0), b3, voffB); PG8_STAGE(PG8_SB(1, 1), b3 + hstepB, voffB); PG8_STAGE(PG8_SA(1, 0), a3, voffA); \
            PG8_WAIT_V(8); PG8_WAIT_L(0); PG8_BAR; PG8_MMA(1, 0, At, B0); PG8_MMA(1, 1, At, B1); PG8_BAR; PG8_SCHED; } while (0)
#define PG8_W12_RELAX do { if (relax) asm volatile("s_waitcnt vmcnt(%0)" :: "i"(8 + Epi::EPI_VM) : "memory"); else PG8_WAIT_V(8); } while (0)
        { const int t = 0; const bool relax = __builtin_amdgcn_readfirstlane((int)(ui > 0)) != 0; PG8_ITER(PG8_MMAZ, PG8_W12_RELAX); }
        for (int t = 2; t < nt; t += 2) PG8_ITER(PG8_MMA, PG8_WAIT_V(8));
#undef PG8_W12_RELAX
#undef PG8_ITER
        if (wr == 0) PG8_BAR;
        { int tz = MY_TID(wave); asm volatile("" : "+v"(tz));
          const int wid2 = tz >> 6, lane2 = tz & 63;
          if constexpr (Epi::RSTD) {
              float rs[8];
              { const int ra = (int)(uintptr_t)lds + RS_LDS + ((wid2 >> 2) * 64 + (lane2 & 15)) * 32;
                f32x4 sa[8], sb[8];
#define PG8_RS_RD(k, OFF) sa[k] = lds_rd128f<(OFF) * 32>(ra); sb[k] = lds_rd128f<(OFF) * 32 + 16>(ra)
                PG8_RS_RD(0, 0); PG8_RS_RD(1, 16); PG8_RS_RD(2, 32); PG8_RS_RD(3, 48); PG8_RS_RD(4, 128); PG8_RS_RD(5, 144); PG8_RS_RD(6, 160); PG8_RS_RD(7, 176);
#undef PG8_RS_RD
                asm volatile("s_waitcnt lgkmcnt(0)" : "+v"(sa[0]), "+v"(sa[1]), "+v"(sa[2]), "+v"(sa[3]), "+v"(sa[4]), "+v"(sa[5]), "+v"(sa[6]), "+v"(sa[7]),
                                                        "+v"(sb[0]), "+v"(sb[1]), "+v"(sb[2]), "+v"(sb[3]), "+v"(sb[4]), "+v"(sb[5]), "+v"(sb[6]), "+v"(sb[7]) :: "memory");
#pragma unroll
                for (int k = 0; k < 8; ++k) { const float s = ((sa[k].x + sa[k].y) + (sa[k].z + sa[k].w)) + ((sb[k].x + sb[k].y) + (sb[k].z + sb[k].w)); rs[k] = __builtin_amdgcn_rsqf(s * Epi::INV_N + RMS_EPS); } }
              PG8_BAR;
              E.run_rs(acc, cur, wid2 >> 2, wid2 & 3, lane2 & 15, lane2 >> 4, rs);
              if (has_next) PG8_RS_DMA(nxt.pm);
          }
          else E(acc, cur, wid2 >> 2, wid2 & 3, lane2 & 15, lane2 >> 4);
          if (Epi::PROBE2 && PROBE_EPI > 1) { asm volatile("" : "+v"(tz)); const int wid3 = tz >> 6, lane3 = tz & 63; E.second(acc, cur, wid3 >> 2, wid3 & 3, lane3 & 15, lane3 >> 4); } }
        if (!has_next) break;
        cur = nxt; cA = nA; cB = nB; ++ui;
        if (wr == 1) PG8_BAR;
    }
    PG8_WAIT_V(0);
    PG8_BAR;
#undef PG8_RS_DMA
#undef PG8_SA
#undef PG8_SB
#undef PG8_STAGE
#undef PG8_LDA
#undef PG8_LDB
#undef PG8_MMA
#undef PG8_MMAZ
#undef PG8_WAIT_V
#undef PG8_WAIT_L
#undef PG8_BAR
#undef PG8_SCHED
}
}

__device__ __forceinline__ float rsq(float x) { return __builtin_amdgcn_rsqf(x); }
constexpr float QS128 = 0.08838834764831845f * 1.4426950408889634f;
constexpr float QS192 = 0.07216878364870322f * 1.4426950408889634f;
__device__ __forceinline__ void rstd8_8(const float* ss, int row0, float inv_n, float (&rs)[8]) {
#pragma unroll
    for (int h = 0; h < 2; ++h) {
        f32x4 a[4], b[4];
#pragma unroll
        for (int i = 0; i < 4; ++i) { const f32x4* p = (const f32x4*)(ss + (size_t)(row0 + h * 128 + i * 16) * 8); a[i] = p[0]; b[i] = p[1]; }
#pragma unroll
        for (int i = 0; i < 4; ++i) { const float s = ((a[i].x + a[i].y) + (a[i].z + a[i].w)) + ((b[i].x + b[i].y) + (b[i].z + b[i].w)); rs[h * 4 + i] = rsq(s * inv_n + RMS_EPS); }
        asm volatile("" : "+v"(rs[h * 4 + 0]), "+v"(rs[h * 4 + 1]), "+v"(rs[h * 4 + 2]), "+v"(rs[h * 4 + 3]));
    }
}
__device__ __forceinline__ void rs_issue(const float* ss, int row0, int h, f32x4 (&a)[4], f32x4 (&b)[4]) {
#pragma unroll
    for (int i = 0; i < 4; ++i) { const f32x4* p = (const f32x4*)(ss + (size_t)(row0 + h * 128 + i * 16) * 8); a[i] = p[0]; b[i] = p[1]; }
}
__device__ __forceinline__ void rs_finish(const f32x4 (&a)[4], const f32x4 (&b)[4], float inv_n, float* rs) {
#pragma unroll
    for (int i = 0; i < 4; ++i) { const float s = ((a[i].x + a[i].y) + (a[i].z + a[i].w)) + ((b[i].x + b[i].y) + (b[i].z + b[i].w)); rs[i] = rsq(s * inv_n + RMS_EPS); }
}
__device__ __forceinline__ u32x4 pack8(const f32x4 v0, const f32x4 v1) {
    u32x4 w; w.x = cvt_pk_bf16(v0[0], v0[1]); w.y = cvt_pk_bf16(v0[2], v0[3]); w.z = cvt_pk_bf16(v1[0], v1[1]); w.w = cvt_pk_bf16(v1[2], v1[3]); return w;
}
__device__ __forceinline__ float sq4(const f32x4 v) { return (v[0] * v[0] + v[1] * v[1]) + (v[2] * v[2] + v[3] * v[3]); }

template <int SRC> struct EpiScaleBf16 {
    static constexpr bool PROBE2 = (PROBE_EPI_WHICH == 1) && (SRC == 1), PREFETCH = false, RSTD = (SRC != 0);
    static constexpr int EPI_VM = 16 + (SRC != 0 ? 1 : 0);
    static constexpr float INV_N = (SRC == 1) ? 1.0f / 2048.0f : 1.0f / 512.0f;
    bf16_t* O; int ldc; const float* ss;
    __device__ __forceinline__ const float* rs_src() const { return ss; }
    __device__ __forceinline__ void run_rs(const f32x4 (&acc)[2][2][4][2], const pg8::Unit& u, int wr, int wc, int fr, int fq, const float (&rs)[8]) const { store(acc, u, wr, wc, fr, fq, rs, 0); store(acc, u, wr, wc, fr, fq, rs, 1); }
    __device__ __forceinline__ void rs_first(const pg8::Unit& u, int wr, int fr, float (&rs)[8]) const { rstd8_8(ss, u.pm * 256 + wr * 64 + fr, INV_N, rs); }
    __device__ __forceinline__ void second(const f32x4 (&acc)[2][2][4][2], const pg8::Unit& u, int wr, int wc, int fr, int fq) const { float rs[8]; rs_first(u, wr, fr, rs); store(acc, u, wr, wc, fr, fq, rs, 0); store(acc, u, wr, wc, fr, fq, rs, 1); }
    __device__ __forceinline__ void store(const f32x4 (&acc)[2][2][4][2], const pg8::Unit& u, int wr, int wc, int fr, int fq, const float (&rs)[8], const int ai) const {
        const int row0 = u.pm * 256 + wr * 64 + fr, col0 = u.pn * 256 + wc * 32 + 8 * fq;
        const float qs = (SRC == 1 && (u.pn < 6 || u.pn >= 18)) ? QS128 : 1.0f;
#pragma unroll
        for (int m = 0; m < 4; ++m) { bf16_t* rowp = O + (size_t)(row0 + ai * 128 + m * 16) * ldc + col0; const float s = SRC ? rs[ai * 4 + m] * qs : 1.0f;
#pragma unroll
            for (int bj = 0; bj < 2; ++bj) *(u32x4*)(rowp + bj * 128) = pack8(acc[ai][bj][m][0] * s, acc[ai][bj][m][1] * s); }
    }
    __device__ __forceinline__ void operator()(const f32x4 (&acc)[2][2][4][2], const pg8::Unit& u, int wr, int wc, int fr, int fq) const {
        float rs[8]; if (SRC) rs_first(u, wr, fr, rs); store(acc, u, wr, wc, fr, fq, rs, 0); store(acc, u, wr, wc, fr, fq, rs, 1);
    }
    __device__ __forceinline__ void run(const f32x4 (&acc)[2][2][4][2], const pg8::Unit& u, int wr, int wc, int fr, int fq, const float (&rs)[8], bool has_next, const pg8::Unit& nx, float (&rsn)[8]) const {
        const int nrow0 = nx.pm * 256 + wr * 64 + fr;
        f32x4 na[4], nb[4];
        if (has_next) rs_issue(ss, nrow0, 0, na, nb);
        store(acc, u, wr, wc, fr, fq, rs, 0);
        if (has_next) { rs_finish(na, nb, INV_N, &rsn[0]); asm volatile("" : "+v"(rsn[0]), "+v"(rsn[1]), "+v"(rsn[2]), "+v"(rsn[3])); rs_issue(ss, nrow0, 1, na, nb); }
        store(acc, u, wr, wc, fr, fq, rs, 1);
        if (has_next) { rs_finish(na, nb, INV_N, &rsn[4]); asm volatile("" : "+v"(rsn[4]), "+v"(rsn[5]), "+v"(rsn[6]), "+v"(rsn[7])); }
    }
};
__device__ __forceinline__ f32x4 bf2f_lo(const u32x4 w) { return (f32x4){__uint_as_float(w.x << 16), __uint_as_float(w.x & 0xffff0000u), __uint_as_float(w.y << 16), __uint_as_float(w.y & 0xffff0000u)}; }
__device__ __forceinline__ f32x4 bf2f_hi(const u32x4 w) { return (f32x4){__uint_as_float(w.z << 16), __uint_as_float(w.z & 0xffff0000u), __uint_as_float(w.w << 16), __uint_as_float(w.w & 0xffff0000u)}; }
template <bool INF32, bool OUTF32> struct EpiResid {
    static constexpr bool PROBE2 = (PROBE_EPI_WHICH == 2) && !INF32 && !OUTF32, PREFETCH = false, RSTD = false;
    static constexpr int EPI_VM = 16;
    const float* hin; float* hout; bf16_t* hb; float* ss; LAS float* red;
    __device__ __forceinline__ void operator()(const f32x4 (&acc)[2][2][4][2], const pg8::Unit& u, int wr, int wc, int fr, int fq) const { run(acc, u, wr, wc, fr, fq, 1.0f); }
    __device__ __forceinline__ void second(const f32x4 (&acc)[2][2][4][2], const pg8::Unit& u, int wr, int wc, int fr, int fq) const { run(acc, u, wr, wc, fr, fq, 0.0f); }
    __device__ __forceinline__ void run(const f32x4 (&acc)[2][2][4][2], const pg8::Unit& u, int wr, int wc, int fr, int fq, const float sc) const {
        const int row0 = u.pm * 256 + wr * 64 + fr, col0 = u.pn * 256 + wc * 32 + 8 * fq;
        constexpr int NB = INF32 ? 2 : 1, AB = 2 / NB;
#pragma unroll
        for (int b = 0; b < NB; ++b) {
            u32x4 hw[AB][4][2]; f32x4 ha[AB][4][2], hc[AB][4][2];
#pragma unroll
            for (int a2 = 0; a2 < AB; ++a2)
#pragma unroll
                for (int m = 0; m < 4; ++m)
#pragma unroll
                    for (int bj = 0; bj < 2; ++bj) { const int ai = b * AB + a2; const size_t off = (size_t)(row0 + ai * 128 + m * 16) * DM + col0 + bj * 128;
                        if (INF32) { ha[a2][m][bj] = *(const f32x4*)(hin + off); hc[a2][m][bj] = *(const f32x4*)(hin + off + 4); }
                        else hw[a2][m][bj] = *(const u32x4*)(hb + off); }
#pragma unroll
            for (int a2 = 0; a2 < AB; ++a2) { const int ai = b * AB + a2;
#pragma unroll
                for (int m = 0; m < 4; ++m) { const int row = row0 + ai * 128 + m * 16; const size_t off = (size_t)row * DM + col0; float q = 0.f;
#pragma unroll
                    for (int bj = 0; bj < 2; ++bj) {
                        const f32x4 r0 = INF32 ? ha[a2][m][bj] : bf2f_lo(hw[a2][m][bj]), r1 = INF32 ? hc[a2][m][bj] : bf2f_hi(hw[a2][m][bj]);
                        const f32x4 v0 = PROBE2 ? r0 + acc[ai][bj][m][0] * sc : r0 + acc[ai][bj][m][0], v1 = PROBE2 ? r1 + acc[ai][bj][m][1] * sc : r1 + acc[ai][bj][m][1];
                        if (OUTF32) { *(f32x4*)(hout + off + bj * 128) = v0; *(f32x4*)(hout + off + bj * 128 + 4) = v1; }
                        else *(u32x4*)(hb + off + bj * 128) = pack8(v0, v1);
                        q += sq4(v0) + sq4(v1); }
                    q += __shfl_xor(q, 16); q += __shfl_xor(q, 32);
                    if (fq == 0) red[(ai * 128 + wr * 64 + m * 16 + fr) * 4 + wc] = q; }
            }
        }
        asm volatile("s_waitcnt lgkmcnt(0)" ::: "memory"); __builtin_amdgcn_s_barrier(); asm volatile("" ::: "memory");
        int tz = ((wr * 4 + wc) << 6) | (fq * 16 + fr); asm volatile("" : "+v"(tz));
        if (tz < 256) { const f32x4 r = *(const LAS f32x4*)(red + tz * 4); ss[(size_t)(u.pm * 256 + tz) * 8 + u.pn] = (r.x + r.y) + (r.z + r.w); }
    }
};
struct EpiSwiglu {
    static constexpr bool PROBE2 = (PROBE_EPI_WHICH == 0), PREFETCH = false, RSTD = true;
    static constexpr int EPI_VM = 8 + 1;
    static constexpr float INV_N = 1.0f / 2048.0f;
    bf16_t* H; const float* ss; int coloff;
    __device__ __forceinline__ const float* rs_src() const { return ss; }
    __device__ __forceinline__ void run_rs(const f32x4 (&acc)[2][2][4][2], const pg8::Unit& u, int wr, int wc, int fr, int fq, const float (&rs)[8]) const { half(acc, u, wr, wc, fr, fq, rs, 0); half(acc, u, wr, wc, fr, fq, rs, 1); }
    __device__ __forceinline__ void rs_first(const pg8::Unit& u, int wr, int fr, float (&rs)[8]) const { rstd8_8(ss, u.pm * 256 + wr * 64 + fr, 1.0f / 2048.0f, rs); }
    __device__ __forceinline__ void second(const f32x4 (&acc)[2][2][4][2], const pg8::Unit& u, int wr, int wc, int fr, int fq) const { float rs[8]; rs_first(u, wr, fr, rs); half(acc, u, wr, wc, fr, fq, rs, 0); half(acc, u, wr, wc, fr, fq, rs, 1); }
    __device__ __forceinline__ void operator()(const f32x4 (&acc)[2][2][4][2], const pg8::Unit& u, int wr, int wc, int fr, int fq) const { second(acc, u, wr, wc, fr, fq); }
    __device__ __forceinline__ void half(const f32x4 (&acc)[2][2][4][2], const pg8::Unit& u, int wr, int wc, int fr, int fq, const float (&rs)[8], const int ai) const {
        const int row0 = u.pm * 256 + wr * 64 + fr, col0 = coloff + u.pn * 128 + wc * 32 + 8 * fq;
#pragma unroll
        for (int m = 0; m < 4; ++m) { const float s = rs[ai * 4 + m], sn = s * -1.4426950408889634f, s2 = s * s; f32x4 o[2];
#pragma unroll
            for (int n = 0; n < 2; ++n) { const f32x4 g = acc[ai][0][m][n]; const f32x4 t = g * sn; const f32x4 gu = g * acc[ai][1][m][n]; f32x4 r;
#pragma unroll
                for (int j = 0; j < 4; ++j) r[j] = __builtin_amdgcn_rcpf(1.0f + __builtin_amdgcn_exp2f(t[j]));
                o[n] = gu * (r * s2); }
            __builtin_nontemporal_store(pack8(o[0], o[1]), (u32x4*)(H + (size_t)(row0 + ai * 128 + m * 16) * FFN + col0)); }
    }
    __device__ __forceinline__ void run(const f32x4 (&acc)[2][2][4][2], const pg8::Unit& u, int wr, int wc, int fr, int fq, const float (&rs)[8], bool has_next, const pg8::Unit& nx, float (&rsn)[8]) const {
        const int nrow0 = nx.pm * 256 + wr * 64 + fr;
        f32x4 na[4], nb[4];
        if (has_next) rs_issue(ss, nrow0, 0, na, nb);
        half(acc, u, wr, wc, fr, fq, rs, 0);
        if (has_next) { rs_finish(na, nb, 1.0f / 2048.0f, &rsn[0]); asm volatile("" : "+v"(rsn[0]), "+v"(rsn[1]), "+v"(rsn[2]), "+v"(rsn[3])); rs_issue(ss, nrow0, 1, na, nb); }
        half(acc, u, wr, wc, fr, fq, rs, 1);
        if (has_next) { rs_finish(na, nb, 1.0f / 2048.0f, &rsn[4]); asm volatile("" : "+v"(rsn[4]), "+v"(rsn[5]), "+v"(rsn[6]), "+v"(rsn[7])); }
    }
};
struct EpiNull {
    static constexpr bool PROBE2 = false, PREFETCH = false, RSTD = false;
    static constexpr int EPI_VM = 0;
    __device__ __forceinline__ void second(const f32x4 (&acc)[2][2][4][2], const pg8::Unit& u, int wr, int wc, int fr, int fq) const {}
    float* sink;
    __device__ __forceinline__ void operator()(const f32x4 (&acc)[2][2][4][2], const pg8::Unit& u, int wr, int wc, int fr, int fq) const {
        f32x4 s = (f32x4){0.f, 0.f, 0.f, 0.f};
#pragma unroll
        for (int ai = 0; ai < 2; ++ai)
#pragma unroll
            for (int bj = 0; bj < 2; ++bj)
#pragma unroll
                for (int m = 0; m < 4; ++m) { s += acc[ai][bj][m][0]; s += acc[ai][bj][m][1]; }
        const float t = (s.x + s.y) + (s.z + s.w);
        if (t != t) sink[0] = t;
    }
};
__device__ __forceinline__ void rope4(f32x4& x1, f32x4& x2, const float* cosT, const float* sinT, int row, int i0) {
    const f32x4 c = *(const f32x4*)(cosT + (size_t)row * 32 + i0), s = *(const f32x4*)(sinT + (size_t)row * 32 + i0);
    const f32x4 o1 = x1 * c - x2 * s, o2 = x2 * c + x1 * s; x1 = o1; x2 = o2;
}
struct EpiBIn {
    static constexpr bool PROBE2 = false, PREFETCH = false, RSTD = true;
    static constexpr int EPI_VM = 0;
    static constexpr float INV_N = 1.0f / 2048.0f;
    __device__ __forceinline__ void second(const f32x4 (&acc)[2][2][4][2], const pg8::Unit& u, int wr, int wc, int fr, int fq) const {}
    bf16_t* pb; bf16_t* kr; const float* ss; float* ssq; float* ssl; const float* cosT; const float* sinT;
    __device__ __forceinline__ const float* rs_src() const { return ss; }
    __device__ __forceinline__ void run_rs(const f32x4 (&acc)[2][2][4][2], const pg8::Unit& u, int wr, int wc, int fr, int fq, const float (&rs)[8]) const {
        const int row0 = u.pm * 256 + wr * 64 + fr, col0 = u.pn * 256 + wc * 32 + 8 * fq, pn = u.pn;
        if (pn < 6) {
            const bool want = (pn < 2) || (pn >= 4); float* sqp = (pn < 2) ? ssq : ssl; const int slot = (pn & 1) * 4 + wc;
#pragma unroll
            for (int ai = 0; ai < 2; ++ai)
#pragma unroll
                for (int m = 0; m < 4; ++m) { const int row = row0 + ai * 128 + m * 16; const float s = rs[ai * 4 + m] * (want ? 1.0f : QS128); float q = 0.f;
#pragma unroll
                    for (int bj = 0; bj < 2; ++bj) { const f32x4 v0 = acc[ai][bj][m][0] * s, v1 = acc[ai][bj][m][1] * s;
                        *(u32x4*)(pb + (size_t)row * PB_LD + col0 + bj * 128) = pack8(v0, v1); q += sq4(v0) + sq4(v1); }
                    q += __shfl_xor(q, 16); q += __shfl_xor(q, 32);
                    if (want && fq == 0) sqp[(size_t)row * 8 + slot] = q; }
        } else if (wc < 2) {
            const int i0 = 4 * (4 * wc + fq);
#pragma unroll
            for (int ai = 0; ai < 2; ++ai)
#pragma unroll
                for (int m = 0; m < 4; ++m) { const int row = row0 + ai * 128 + m * 16; const float s = rs[ai * 4 + m];
                    f32x4 x1 = acc[ai][0][m][0] * s, x2 = acc[ai][0][m][1] * s; rope4(x1, x2, cosT, sinT, row, i0);
                    *(u32x4*)(kr + (size_t)row * 64 + wc * 32 + 8 * fq) = pack8(x1, x2); }
        }
    }
};
struct EpiUq {
    static constexpr bool PROBE2 = false, PREFETCH = false, RSTD = true;
    static constexpr int EPI_VM = 16 + 1;
    static constexpr float INV_N = 1.0f / 512.0f;
    __device__ __forceinline__ void second(const f32x4 (&acc)[2][2][4][2], const pg8::Unit& u, int wr, int wc, int fr, int fq) const {}
    bf16_t* q; const float* ssq; const float* cosT; const float* sinT;
    __device__ __forceinline__ const float* rs_src() const { return ssq; }
    __device__ __forceinline__ void run_rs(const f32x4 (&acc)[2][2][4][2], const pg8::Unit& u, int wr, int wc, int fr, int fq, const float (&rs)[8]) const {
        const int row0 = u.pm * 256 + wr * 64 + fr, col0 = u.pn * 256 + wc * 32 + 8 * fq;
        const int i0 = 4 * (4 * (wc & 1) + fq);
#pragma unroll
        for (int ai = 0; ai < 2; ++ai)
#pragma unroll
            for (int m = 0; m < 4; ++m) { const int row = row0 + ai * 128 + m * 16; const float s = rs[ai * 4 + m] * QS192;
#pragma unroll
                for (int bj = 0; bj < 2; ++bj) { f32x4 v0 = acc[ai][bj][m][0] * s, v1 = acc[ai][bj][m][1] * s;
                    const int gb = 4 * u.pn + 2 * bj + (wc >> 1);
                    if (gb % 3 == 2) rope4(v0, v1, cosT, sinT, row, i0);
                    *(u32x4*)(q + (size_t)row * UQ_N + col0 + bj * 128) = pack8(v0, v1); } }
    }
};

namespace att {
__device__ __forceinline__ int crow(int r, int hi) { return (r & 3) + 8 * (r >> 2) + 4 * hi; }
__device__ __forceinline__ int key2slot(int k) { const int hi = k >> 5, h = (k >> 4) & 1, r = k & 15; return 32 * h + (r & 3) + 8 * (r >> 2) + 4 * hi; }
__device__ __forceinline__ int slot2key(int s) { const int h = s >> 5, rho = s & 31, hi = (rho >> 2) & 1, r = (rho & 3) | ((rho >> 3) << 2); return 32 * hi + 16 * h + r; }
__device__ __forceinline__ int v_st(int k, int c) { const int kk = (k & ~0xC) | ((k & 4) << 1) | ((k & 8) >> 1); return ((kk >> 3) * 4 + (c >> 5)) * 512 + ((kk & 7) * 32 + (c & 31)) * 2; }
__device__ __forceinline__ int v_rd_base(int lane) { return ((lane & 3) << 3) | (((lane >> 2) & 3) << 6) | (((lane >> 4) & 1) << 5) | (((lane >> 5) & 1) << 8); }
constexpr int v_rd_off(int d0, int ks, int half) { return d0 * 512 + ks * 4096 + half * 2048; }
template <int OFF> __device__ __forceinline__ bf16x8 lds_rd128(int addr) { bf16x8 r; asm volatile("ds_read_b128 %0, %1 offset:%2" : "=&v"(r) : "v"(addr), "i"(OFF) : "memory"); return r; }
__device__ __forceinline__ float lds_rd32(int addr) { float r; asm volatile("ds_read_b32 %0, %1" : "=&v"(r) : "v"(addr) : "memory"); return r; }
__device__ __forceinline__ unsigned lds_rd32u(int addr) { unsigned r; asm volatile("ds_read_b32 %0, %1" : "=&v"(r) : "v"(addr) : "memory"); return r; }
__device__ __forceinline__ void lds_wr32(int addr, float v) { asm volatile("ds_write_b32 %0, %1" :: "v"(addr), "v"(v) : "memory"); }
__device__ __forceinline__ void lds_wr32u(int addr, unsigned v) { asm volatile("ds_write_b32 %0, %1" :: "v"(addr), "v"(v) : "memory"); }
#define ATT_LGKM0() asm volatile("s_waitcnt lgkmcnt(0)" ::: "memory")
template <int OFF> __device__ __forceinline__ s16x4 tr_read(int vb) {
    s16x4 r; asm volatile("ds_read_b64_tr_b16 %0, %1 offset:%2" : "=&v"(r) : "v"(vb), "i"(OFF) : "memory"); return r;
}
struct VFrag { s16x4 l0, h0, l1, h1, l2, h2, l3, h3; };
template <int D0> __device__ __forceinline__ void pv_issue(VFrag& f, int vb) {
    f.l0 = tr_read<v_rd_off(D0, 0, 0)>(vb); f.h0 = tr_read<v_rd_off(D0, 0, 1)>(vb); f.l1 = tr_read<v_rd_off(D0, 1, 0)>(vb); f.h1 = tr_read<v_rd_off(D0, 1, 1)>(vb);
    f.l2 = tr_read<v_rd_off(D0, 2, 0)>(vb); f.h2 = tr_read<v_rd_off(D0, 2, 1)>(vb); f.l3 = tr_read<v_rd_off(D0, 3, 0)>(vb); f.h3 = tr_read<v_rd_off(D0, 3, 1)>(vb);
}
template <int N> __device__ __forceinline__ void pv_wait(VFrag& f) {
    asm volatile("s_waitcnt lgkmcnt(%8)" : "+v"(f.l0), "+v"(f.h0), "+v"(f.l1), "+v"(f.h1), "+v"(f.l2), "+v"(f.h2), "+v"(f.l3), "+v"(f.h3) : "i"(N) : "memory");
    __builtin_amdgcn_sched_barrier(0);
}
__device__ __forceinline__ void pv_mma(f32x16& od, const VFrag& f, bf16x8 pb0, bf16x8 pb1, bf16x8 pb2, bf16x8 pb3) {
#define ATT_PK(L, H) (bf16x8){L[0], L[1], L[2], L[3], H[0], H[1], H[2], H[3]}
    od = __builtin_amdgcn_mfma_f32_32x32x16_bf16(ATT_PK(f.l0, f.h0), pb0, od, 0, 0, 0);
    od = __builtin_amdgcn_mfma_f32_32x32x16_bf16(ATT_PK(f.l1, f.h1), pb1, od, 0, 0, 0);
    od = __builtin_amdgcn_mfma_f32_32x32x16_bf16(ATT_PK(f.l2, f.h2), pb2, od, 0, 0, 0);
    od = __builtin_amdgcn_mfma_f32_32x32x16_bf16(ATT_PK(f.l3, f.h3), pb3, od, 0, 0, 0);
#undef ATT_PK
    __builtin_amdgcn_sched_barrier(0);
}
__device__ __forceinline__ void pv_tile(f32x16 (&o)[4], int vb, bf16x8 pa0, bf16x8 pa1, bf16x8 pa2, bf16x8 pa3) {
    VFrag x, y;
    pv_issue<0>(x, vb); pv_issue<1>(y, vb);
    pv_wait<8>(x); pv_mma(o[0], x, pa0, pa1, pa2, pa3); pv_issue<2>(x, vb);
    pv_wait<8>(y); pv_mma(o[1], y, pa0, pa1, pa2, pa3); pv_issue<3>(y, vb);
    pv_wait<8>(x); pv_mma(o[2], x, pa0, pa1, pa2, pa3);
    pv_wait<0>(y); pv_mma(o[3], y, pa0, pa1, pa2, pa3);
}
__device__ __forceinline__ float sum16(const f32x16& p) {
    float a, b;
    asm volatile("s_nop 0\n\t"
                 "v_add_f32 %0, %2, %3\n\tv_add_f32 %1, %4, %5\n\t"
                 "v_add_f32 %0, %0, %6\n\tv_add_f32 %1, %1, %7\n\t"
                 "v_add_f32 %0, %0, %8\n\tv_add_f32 %1, %1, %9\n\t"
                 "v_add_f32 %0, %0, %10\n\tv_add_f32 %1, %1, %11\n\t"
                 "v_add_f32 %0, %0, %12\n\tv_add_f32 %1, %1, %13\n\t"
                 "v_add_f32 %0, %0, %14\n\tv_add_f32 %1, %1, %15\n\t"
                 "v_add_f32 %0, %0, %16\n\tv_add_f32 %1, %1, %17"
                 : "=&v"(a), "=&v"(b)
                 : "v"(p[0]), "v"(p[1]), "v"(p[2]), "v"(p[3]), "v"(p[4]), "v"(p[5]), "v"(p[6]), "v"(p[7]),
                   "v"(p[8]), "v"(p[9]), "v"(p[10]), "v"(p[11]), "v"(p[12]), "v"(p[13]), "v"(p[14]), "v"(p[15]));
    return a + b;
}
__device__ __forceinline__ void add1_16(f32x16& p) {
    float e0 = p[0], e1 = p[1], e2 = p[2], e3 = p[3], e4 = p[4], e5 = p[5], e6 = p[6], e7 = p[7], e8 = p[8], e9 = p[9], e10 = p[10], e11 = p[11], e12 = p[12], e13 = p[13], e14 = p[14], e15 = p[15];
    asm volatile("s_nop 0\n\t"
                 "v_add_f32 %0, 1.0, %0\n\tv_add_f32 %1, 1.0, %1\n\tv_add_f32 %2, 1.0, %2\n\tv_add_f32 %3, 1.0, %3\n\t"
                 "v_add_f32 %4, 1.0, %4\n\tv_add_f32 %5, 1.0, %5\n\tv_add_f32 %6, 1.0, %6\n\tv_add_f32 %7, 1.0, %7\n\t"
                 "v_add_f32 %8, 1.0, %8\n\tv_add_f32 %9, 1.0, %9\n\tv_add_f32 %10, 1.0, %10\n\tv_add_f32 %11, 1.0, %11\n\t"
                 "v_add_f32 %12, 1.0, %12\n\tv_add_f32 %13, 1.0, %13\n\tv_add_f32 %14, 1.0, %14\n\tv_add_f32 %15, 1.0, %15"
                 : "+v"(e0), "+v"(e1), "+v"(e2), "+v"(e3), "+v"(e4), "+v"(e5), "+v"(e6), "+v"(e7), "+v"(e8), "+v"(e9), "+v"(e10), "+v"(e11), "+v"(e12), "+v"(e13), "+v"(e14), "+v"(e15));
    p = (f32x16){e0, e1, e2, e3, e4, e5, e6, e7, e8, e9, e10, e11, e12, e13, e14, e15};
}
__device__ __forceinline__ void diff16(f32x16& p, float& prev) {
    float e0 = p[0], e1 = p[1], e2 = p[2], e3 = p[3], e4 = p[4], e5 = p[5], e6 = p[6], e7 = p[7], e8 = p[8], e9 = p[9], e10 = p[10], e11 = p[11], e12 = p[12], e13 = p[13], e14 = p[14], e15 = p[15];
    float nprev;
    asm volatile("s_nop 0\n\t"
                 "v_mov_b32 %16, %0\n\t"
                 "v_sub_f32 %0, %1, %0\n\tv_sub_f32 %1, %2, %1\n\tv_sub_f32 %2, %3, %2\n\tv_sub_f32 %3, %4, %3\n\t"
                 "v_sub_f32 %4, %5, %4\n\tv_sub_f32 %5, %6, %5\n\tv_sub_f32 %6, %7, %6\n\tv_sub_f32 %7, %8, %7\n\t"
                 "v_sub_f32 %8, %9, %8\n\tv_sub_f32 %9, %10, %9\n\tv_sub_f32 %10, %11, %10\n\tv_sub_f32 %11, %12, %11\n\t"
                 "v_sub_f32 %12, %13, %12\n\tv_sub_f32 %13, %14, %13\n\tv_sub_f32 %14, %15, %14\n\tv_sub_f32 %15, %17, %15"
                 : "+v"(e0), "+v"(e1), "+v"(e2), "+v"(e3), "+v"(e4), "+v"(e5), "+v"(e6), "+v"(e7), "+v"(e8), "+v"(e9), "+v"(e10), "+v"(e11), "+v"(e12), "+v"(e13), "+v"(e14), "+v"(e15), "=&v"(nprev)
                 : "v"(prev));
    p = (f32x16){e0, e1, e2, e3, e4, e5, e6, e7, e8, e9, e10, e11, e12, e13, e14, e15};
    prev = nprev;
}
__device__ __forceinline__ void cumprod_hi(f32x16& a, f32x16& b) {
    float a8 = a[8], a9 = a[9], a10 = a[10], a11 = a[11], a12 = a[12], a13 = a[13], a14 = a[14], a15 = a[15], b8 = b[8], b9 = b[9], b10 = b[10], b11 = b[11], b12 = b[12], b13 = b[13], b14 = b[14], b15 = b[15];
    asm volatile("v_mul_f32 %6, %7, %6\n\tv_mul_f32 %14, %15, %14\n\tv_mul_f32 %5, %6, %5\n\tv_mul_f32 %13, %14, %13\n\t"
                 "v_mul_f32 %4, %5, %4\n\tv_mul_f32 %12, %13, %12\n\tv_mul_f32 %3, %4, %3\n\tv_mul_f32 %11, %12, %11\n\t"
                 "v_mul_f32 %2, %3, %2\n\tv_mul_f32 %10, %11, %10\n\tv_mul_f32 %1, %2, %1\n\tv_mul_f32 %9, %10, %9\n\t"
                 "v_mul_f32 %0, %1, %0\n\tv_mul_f32 %8, %9, %8"
                 : "+v"(a8), "+v"(a9), "+v"(a10), "+v"(a11), "+v"(a12), "+v"(a13), "+v"(a14), "+v"(a15), "+v"(b8), "+v"(b9), "+v"(b10), "+v"(b11), "+v"(b12), "+v"(b13), "+v"(b14), "+v"(b15));
    a[8] = a8; a[9] = a9; a[10] = a10; a[11] = a11; a[12] = a12; a[13] = a13; a[14] = a14; b[8] = b8; b[9] = b9; b[10] = b10; b[11] = b11; b[12] = b12; b[13] = b13; b[14] = b14;
}
__device__ __forceinline__ void cumprod_lo(f32x16& a, f32x16& b) {
    float a0 = a[0], a1 = a[1], a2 = a[2], a3 = a[3], a4 = a[4], a5 = a[5], a6 = a[6], a7 = a[7], b0 = b[0], b1 = b[1], b2 = b[2], b3 = b[3], b4 = b[4], b5 = b[5], b6 = b[6], b7 = b[7];
    asm volatile("v_mul_f32 %7, %16, %7\n\tv_mul_f32 %15, %17, %15\n\tv_mul_f32 %6, %7, %6\n\tv_mul_f32 %14, %15, %14\n\t"
                 "v_mul_f32 %5, %6, %5\n\tv_mul_f32 %13, %14, %13\n\tv_mul_f32 %4, %5, %4\n\tv_mul_f32 %12, %13, %12\n\t"
                 "v_mul_f32 %3, %4, %3\n\tv_mul_f32 %11, %12, %11\n\tv_mul_f32 %2, %3, %2\n\tv_mul_f32 %10, %11, %10\n\t"
                 "v_mul_f32 %1, %2, %1\n\tv_mul_f32 %9, %10, %9\n\tv_mul_f32 %0, %1, %0\n\tv_mul_f32 %8, %9, %8"
                 : "+v"(a0), "+v"(a1), "+v"(a2), "+v"(a3), "+v"(a4), "+v"(a5), "+v"(a6), "+v"(a7), "+v"(b0), "+v"(b1), "+v"(b2), "+v"(b3), "+v"(b4), "+v"(b5), "+v"(b6), "+v"(b7)
                 : "v"(a[8]), "v"(b[8]));
    a[0] = a0; a[1] = a1; a[2] = a2; a[3] = a3; a[4] = a4; a[5] = a5; a[6] = a6; a[7] = a7; b[0] = b0; b[1] = b1; b[2] = b2; b[3] = b3; b[4] = b4; b[5] = b5; b[6] = b6; b[7] = b7;
}
struct Args { const bf16_t* Q; int ldq; const bf16_t* K; int ldk; const bf16_t* Kr; int ldkr; const bf16_t* V; int ldv; bf16_t* O; int ldo; int q0; int ntiles; int wave; };

constexpr int AK_BUF = 24576, AV_OFF = 2 * AK_BUF, AV_BUF = 16384, AST_OFF = AV_OFF + 2 * AV_BUF, AFLAG_OFF = AST_OFF + 2048;
#define ATT_BAR() do { asm volatile("s_waitcnt lgkmcnt(0)" ::: "memory"); __builtin_amdgcn_s_barrier(); asm volatile("" ::: "memory"); } while (0)
template <int MODE, int DQK>
__device__ __forceinline__ void attn_unit(LAS unsigned char* lds, const Args& a) {
    constexpr int ND = DQK / 16;
    constexpr float THRS = 8.0f * 1.4426950408889634f;
    int tid_ = MY_TID(a.wave); asm volatile("" : "+v"(tid_));
    const int tid = tid_, wid = tid >> 6, lane = tid & 63, r32 = lane & 31, hi = lane >> 5;
    const int grp = __builtin_amdgcn_readfirstlane(wid >> 2);
    const int ldsb = (int)(uintptr_t)lds;
    const int st_a = ldsb + AST_OFF + wid * 256;
    const int fl_a = ldsb + AFLAG_OFF;
    bf16x8 qr[ND];
    { const bf16_t* Qw = a.Q + (size_t)(wid * 32 + r32) * a.ldq + hi * 8;
#pragma unroll
      for (int d0 = 0; d0 < ND; ++d0) qr[d0] = *(const bf16x8*)(Qw + d0 * 16); }
    f32x16 o[4];
#pragma unroll
    for (int d = 0; d < 4; ++d)
#pragma unroll
        for (int r = 0; r < 16; ++r) o[d][r] = 0.f;
    float l_reg = 0.f, carryP = 1.f;
    f32x16 nb;
#pragma unroll
    for (int r = 0; r < 16; ++r) nb[r] = 0.f;
    unsigned voffK[2], voffV[2], voffR;
#pragma unroll
    for (int i = 0; i < 2; ++i) {
        const int A = wid * 2048 + i * 1024 + lane * 16;
        { const int slot = A >> 8, ck = ((A >> 4) & 15) ^ (slot & 15); voffK[i] = (unsigned)(slot2key(slot) * a.ldk + ck * 8) * 2u; }
        { const int sub = A >> 9, within = (A & 511) >> 1, kk = ((sub >> 2) << 3) | (within >> 5), c = ((sub & 3) << 5) | (within & 31);
          const int slot = kk;
          voffV[i] = (unsigned)(slot2key(slot) * a.ldv + c) * 2u; }
    }
    { const int A = wid * 1024 + lane * 16, slot = A >> 7, ck = ((A >> 4) & 7) ^ ((slot >> 1) & 7); voffR = (unsigned)(slot2key(slot) * a.ldkr + ck * 8) * 2u; }
    const int kx = r32 & 15, kxr = (r32 >> 1) & 7;
    int koff[ND];
#pragma unroll
    for (int d0 = 0; d0 < ND; ++d0) { koff[d0] = (d0 < 8) ? (r32 * 256 + (((2 * d0 + hi) ^ kx) << 4)) : (16384 + r32 * 128 + (((2 * (d0 - 8) + hi) ^ kxr) << 4)); asm volatile("" : "+v"(koff[d0])); }
    const int vb0 = (int)(uintptr_t)lds + AV_OFF + v_rd_base(lane);
    const int qpos = a.q0 + wid * 32 + r32, qmax = a.q0 + wid * 32 + 31;
    const int nt0 = a.ntiles; int nt = nt0;
#define ATT_TILE(t_) (((MODE == 0) ? (nt0 - 1 - (t_)) : (t_)) * 64)
#define ATT_DMA(gp_, voff_, ldsoff_) do { asm volatile("" : "+v"(voff_)); __builtin_amdgcn_global_load_lds((const unsigned*)(pg8::uptr((const char*)(gp_)) + (voff_)), (LAS unsigned*)(lds + (ldsoff_)), 16, 0, 0); } while (0)
#define ATT_DMAK(t_) do { const int k0_ = ATT_TILE(t_); const int kb_ = ((t_) & 1) * AK_BUF; const bf16_t* kp_ = a.K + (size_t)k0_ * a.ldk; \
        ATT_DMA(kp_, voffK[0], kb_ + a.wave * 2048); ATT_DMA(kp_, voffK[1], kb_ + a.wave * 2048 + 1024); \
        if (DQK == 192) { const bf16_t* rp_ = a.Kr + (size_t)k0_ * a.ldkr; ATT_DMA(rp_, voffR, kb_ + 16384 + a.wave * 1024); } } while (0)
#define ATT_DMAV(t_) do { const int k0_ = ATT_TILE(t_); const int vo_ = AV_OFF + ((t_) & 1) * AV_BUF; const bf16_t* vp_ = a.V + (size_t)k0_ * a.ldv; \
        ATT_DMA(vp_, voffV[0], vo_ + a.wave * 2048); ATT_DMA(vp_, voffV[1], vo_ + a.wave * 2048 + 1024); } while (0)
    if (MODE == 0 && lane < 2) lds_wr32u(fl_a + (lane * 8 + wid) * 4, 0u);
    ATT_BAR();
    ATT_DMAK(0);
    asm volatile("s_waitcnt vmcnt(0)" ::: "memory");
    ATT_BAR();
#pragma unroll
    for (int d0 = 0; d0 < ND; ++d0) asm volatile("" : "+v"(qr[d0]));
    bool actQ = false, actP = false;
    f32x16 p0, p1;
    if (grp == 1) { if (1 < nt0) ATT_DMAK(1); ATT_DMAV(0); ATT_BAR(); }
    for (int t = 0; t <= nt; ++t) {
        if (grp == 0) { if (t + 1 < nt0) ATT_DMAK(t + 1); if (t < nt0) ATT_DMAV(t); }
        else if (MODE == 0 && t >= 1) {
            unsigned fw[8];
#pragma unroll
            for (int w = 0; w < 8; ++w) fw[w] = lds_rd32u(fl_a + (((t - 1) & 1) * 8 + w) * 4);
            asm volatile("s_waitcnt lgkmcnt(0)" : "+v"(fw[0]), "+v"(fw[1]), "+v"(fw[2]), "+v"(fw[3]), "+v"(fw[4]), "+v"(fw[5]), "+v"(fw[6]), "+v"(fw[7]) :: "memory");
            unsigned alld = 1u;
#pragma unroll
            for (int w = 0; w < 8; ++w) alld &= fw[w];
            if (__builtin_amdgcn_readfirstlane(alld) && t < nt) nt = t;
        }
        if (t >= 1 && actP) {
            const int vb = vb0 + ((t - 1) & 1) * AV_BUF;
            u32x4 w0_ = {__float_as_uint(p0[0]), __float_as_uint(p0[1]), __float_as_uint(p0[2]), __float_as_uint(p0[3])}, w1_ = {__float_as_uint(p0[4]), __float_as_uint(p0[5]), __float_as_uint(p0[6]), __float_as_uint(p0[7])};
            u32x4 w2_ = {__float_as_uint(p0[8]), __float_as_uint(p0[9]), __float_as_uint(p0[10]), __float_as_uint(p0[11])}, w3_ = {__float_as_uint(p0[12]), __float_as_uint(p0[13]), __float_as_uint(p0[14]), __float_as_uint(p0[15])};
            const bf16x8 pa0 = __builtin_bit_cast(bf16x8, w0_), pa1 = __builtin_bit_cast(bf16x8, w1_), pa2 = __builtin_bit_cast(bf16x8, w2_), pa3 = __builtin_bit_cast(bf16x8, w3_);
            pv_tile(o, vb, pa0, pa1, pa2, pa3);
        }
        actQ = false;
        if (t < nt) {
            const int k0 = ATT_TILE(t);
            if (MODE == 0) actQ = (k0 < qmax) && !__all(carryP > 1e30f);
            else if (MODE == 1) actQ = (k0 <= qmax);
            else actQ = true;
            if (actQ) {
                const int K_a = ldsb + (t & 1) * AK_BUF;
#pragma unroll
                for (int r = 0; r < 16; ++r) { p0[r] = (MODE == 0) ? 0.f : nb[r]; p1[r] = (MODE == 0) ? 0.f : nb[r]; }
                constexpr int NC = ND / 2;
                bf16x8 xa[2], xb[2], ya[2], yb[2];
#define ATT_QK_ISSUE(c_, A_, B_) do { _Pragma("unroll") for (int i_ = 0; i_ < 2; ++i_) { const int d0 = 2 * (c_) + i_; \
        const int off = koff[d0]; \
        if (d0 < 8) { A_[i_] = lds_rd128<0>(K_a + off); B_[i_] = lds_rd128<32 * 256>(K_a + off); } else { A_[i_] = lds_rd128<0>(K_a + off); B_[i_] = lds_rd128<32 * 128>(K_a + off); } } } while (0)
#define ATT_QK_STEP(c_, A_, B_) do { if ((c_) + 1 < NC) asm volatile("s_waitcnt lgkmcnt(4)" : "+v"(A_[0]), "+v"(B_[0]), "+v"(A_[1]), "+v"(B_[1]) :: "memory"); \
        else asm volatile("s_waitcnt lgkmcnt(0)" : "+v"(A_[0]), "+v"(B_[0]), "+v"(A_[1]), "+v"(B_[1]) :: "memory"); \
        __builtin_amdgcn_sched_barrier(0); \
        p0 = __builtin_amdgcn_mfma_f32_32x32x16_bf16(A_[0], qr[2 * (c_)], p0, 0, 0, 0); p1 = __builtin_amdgcn_mfma_f32_32x32x16_bf16(B_[0], qr[2 * (c_)], p1, 0, 0, 0); \
        p0 = __builtin_amdgcn_mfma_f32_32x32x16_bf16(A_[1], qr[2 * (c_) + 1], p0, 0, 0, 0); p1 = __builtin_amdgcn_mfma_f32_32x32x16_bf16(B_[1], qr[2 * (c_) + 1], p1, 0, 0, 0); \
        __builtin_amdgcn_sched_barrier(0); \
        if ((c_) + 2 < NC) ATT_QK_ISSUE((c_) + 2, A_, B_); } while (0)
                ATT_QK_ISSUE(0, xa, xb); ATT_QK_ISSUE(1, ya, yb);
                ATT_QK_STEP(0, xa, xb); ATT_QK_STEP(1, ya, yb); ATT_QK_STEP(2, xa, xb); ATT_QK_STEP(3, ya, yb);
                if constexpr (NC > 4) { ATT_QK_STEP(4, xa, xb); ATT_QK_STEP(5, ya, yb); }
#undef ATT_QK_ISSUE
#undef ATT_QK_STEP
            }
        }
        if (grp == 1) asm volatile("s_waitcnt vmcnt(0)" ::: "memory");
        ATT_BAR();
        if (grp == 1) { if (t + 2 < nt0) ATT_DMAK(t + 2); if (t + 1 < nt0) ATT_DMAV(t + 1); }
        else if (MODE == 0 && t >= 1) {
            unsigned fw[8];
#pragma unroll
            for (int w = 0; w < 8; ++w) fw[w] = lds_rd32u(fl_a + (((t - 1) & 1) * 8 + w) * 4);
            asm volatile("s_waitcnt lgkmcnt(0)" : "+v"(fw[0]), "+v"(fw[1]), "+v"(fw[2]), "+v"(fw[3]), "+v"(fw[4]), "+v"(fw[5]), "+v"(fw[6]), "+v"(fw[7]) :: "memory");
            unsigned alld = 1u;
#pragma unroll
            for (int w = 0; w < 8; ++w) alld &= fw[w];
            if (__builtin_amdgcn_readfirstlane(alld) && t < nt) nt = t;
        }
        if (t < nt) {
        if (actQ) {
            const int k0 = ATT_TILE(t);
            const bool need_mask = (MODE != 2) && (k0 + 63 >= a.q0 + a.wave * 32);
            const int lim = qpos - (k0 + 32 * hi) + (MODE == 1 ? 1 : 0);
            if (MODE == 0) {
#pragma unroll
                for (int r = 0; r < 16; ++r) { p0[r] = __builtin_amdgcn_exp2f(p0[r]); p1[r] = __builtin_amdgcn_exp2f(p1[r]); }
                add1_16(p0); add1_16(p1);
                if (need_mask) {
#pragma unroll
                    for (int r = 0; r < 16; ++r) { p0[r] = (r < lim) ? p0[r] : 1.0f; p1[r] = (r + 16 < lim) ? p1[r] : 1.0f; }
                }
                cumprod_hi(p1, p0); cumprod_lo(p1, p0);
                const float run1 = p1[0], run0 = p0[0];
                const float run = run1 * run0;
                const auto rr = __builtin_amdgcn_permlane32_swap(__float_as_uint(run), __float_as_uint(run), false, false);
                const float tlo = __uint_as_float(rr[0]), thi = __uint_as_float(rr[1]);
                const float seed1 = carryP * (hi ? 1.0f : thi), seed0 = seed1 * run1;
                float sprev = __builtin_amdgcn_rcpf(seed1);
#pragma unroll
                for (int r = 0; r < 16; ++r) p1[r] = __builtin_amdgcn_rcpf(p1[r] * seed1);
                diff16(p1, sprev);
#pragma unroll
                for (int r = 0; r < 16; ++r) p0[r] = __builtin_amdgcn_rcpf(p0[r] * seed0);
                diff16(p0, sprev);
                carryP *= tlo * thi;
            } else {
                if (need_mask) {
#pragma unroll
                    for (int r = 0; r < 16; ++r) { p0[r] = (r < lim) ? p0[r] : -1e30f; p1[r] = (r + 16 < lim) ? p1[r] : -1e30f; }
                }
                float pmax = p0[0];
#pragma unroll
                for (int r = 1; r < 16; ++r) pmax = fmaxf(pmax, p0[r]);
#pragma unroll
                for (int r = 0; r < 16; ++r) pmax = fmaxf(pmax, p1[r]);
                { const auto rr = __builtin_amdgcn_permlane32_swap(__float_as_uint(pmax), __float_as_uint(pmax), false, false);
                  pmax = fmaxf(__uint_as_float(rr[0]), __uint_as_float(rr[1])); }
                if (t == 0) {
#pragma unroll
                    for (int r = 0; r < 16; ++r) { p0[r] -= pmax; p1[r] -= pmax; nb[r] = -pmax; }
                } else if (!__all(pmax <= THRS)) {
                    const float dm = fmaxf(pmax, 0.f);
                    const float alpha = __builtin_amdgcn_exp2f(-dm);
                    l_reg *= alpha;
#pragma unroll
                    for (int d = 0; d < 4; ++d)
#pragma unroll
                        for (int r = 0; r < 16; ++r) o[d][r] *= alpha;
#pragma unroll
                    for (int r = 0; r < 16; ++r) { p0[r] -= dm; p1[r] -= dm; nb[r] -= dm; }
                }
#pragma unroll
                for (int r = 0; r < 16; ++r) { p0[r] = __builtin_amdgcn_exp2f(p0[r]); p1[r] = __builtin_amdgcn_exp2f(p1[r]); }
                float ps = sum16(p0) + sum16(p1);
                { const auto rr = __builtin_amdgcn_permlane32_swap(__float_as_uint(ps), __float_as_uint(ps), false, false);
                  ps = __uint_as_float(rr[0]) + __uint_as_float(rr[1]); }
                l_reg += ps;
            }
            { unsigned w_[16];
#pragma unroll
              for (int i = 0; i < 8; ++i) { w_[i] = cvt_pk_bf16(p0[2 * i], p0[2 * i + 1]); w_[8 + i] = cvt_pk_bf16(p1[2 * i], p1[2 * i + 1]); }
#pragma unroll
              for (int i = 0; i < 16; ++i) p0[i] = __uint_as_float(w_[i]); }
        }
            actP = actQ;
            if (MODE == 0) { const bool dn = __all(carryP > 1e30f); if (lane == 0) lds_wr32u(fl_a + ((t & 1) * 8 + wid) * 4, dn ? 1u : 0u); }
        }
        if (grp == 0) asm volatile("s_waitcnt vmcnt(0)" ::: "memory");
        ATT_BAR();
    }
    if (grp == 0) ATT_BAR();
    asm volatile("s_waitcnt vmcnt(0)" ::: "memory");
#undef ATT_TILE
#undef ATT_DMA
#undef ATT_DMAK
#undef ATT_DMAV
    int tz = MY_TID(a.wave); asm volatile("" : "+v"(tz));
    const int wid2 = tz >> 6, r32b = tz & 31, hib = (tz >> 5) & 1;
    const float rl = (MODE != 0) ? __builtin_amdgcn_rcpf(l_reg) : 1.0f;
    bf16_t* Ow = a.O + (size_t)(wid2 * 32 + r32b) * a.ldo + 8 * hib;
#pragma unroll
    for (int d0 = 0; d0 < 4; ++d0)
#pragma unroll
        for (int k = 0; k < 2; ++k) {
            unsigned ax = cvt_pk_bf16(o[d0][8 * k + 0] * rl, o[d0][8 * k + 1] * rl), ay = cvt_pk_bf16(o[d0][8 * k + 2] * rl, o[d0][8 * k + 3] * rl);
            unsigned bx = cvt_pk_bf16(o[d0][8 * k + 4] * rl, o[d0][8 * k + 5] * rl), by = cvt_pk_bf16(o[d0][8 * k + 6] * rl, o[d0][8 * k + 7] * rl);
            const auto rx = __builtin_amdgcn_permlane32_swap(ax, bx, false, false); const auto ry = __builtin_amdgcn_permlane32_swap(ay, by, false, false);
            const u32x4 w = {rx[0], ry[0], rx[1], ry[1]};
            *(u32x4*)(Ow + d0 * 32 + 16 * k) = w;
        }
}
}

#define XB_TMO      128
#define XB_XCNT(j)  (256  + 64 * (j))
#define XB_XSUB(j)  (1280 + 64 * (j))
#define XB_XGEN(j)  (2304 + 64 * (j))
#define XB_TOP      3328
#define XB_TOPGEN   3392
#define XCD_BAR_WORDS 3456
#define XB_SPIN_CAP (1u << 22)
__device__ __forceinline__ unsigned xb_ld(unsigned* p)              { return __hip_atomic_load(p, __ATOMIC_RELAXED, __HIP_MEMORY_SCOPE_AGENT); }
__device__ __forceinline__ unsigned xb_add(unsigned* p, unsigned v) { return __hip_atomic_fetch_add(p, v, __ATOMIC_RELAXED, __HIP_MEMORY_SCOPE_AGENT); }
__device__ __forceinline__ unsigned xb_xcc_id() { return (unsigned)__builtin_amdgcn_s_getreg((3 << 11) | 20) & 0xFu; }
#define XB_SPIN(cond, bar) do { unsigned _sp = 0; while (cond) { __builtin_amdgcn_s_sleep(1); \
    if ((++_sp & 255u) == 0u) { if (xb_ld(&(bar)[XB_TMO])) break; if (_sp > XB_SPIN_CAP) { atomicAdd(&(bar)[XB_TMO], 1u); break; } } } } while (0)
struct XcdBarrier { unsigned* bar; unsigned x; volatile LAS unsigned* st; int wave; };
__device__ __forceinline__ XcdBarrier xcd_barrier_post(unsigned* bar, volatile LAS unsigned* st, int wave) {
    XcdBarrier b; b.bar = bar; b.x = xb_xcc_id(); b.st = st; b.wave = wave;
    if (MY_TID(wave) == 0) (void)xb_add(&bar[XB_XCNT(b.x)], 1u);
    return b;
}
__device__ __forceinline__ void xcd_barrier_complete(unsigned* bar, unsigned x, unsigned& nloc, unsigned& nx) {
    const unsigned G = gridDim.x * gridDim.y * gridDim.z;
    unsigned sum, cnt, mine, sp = 0u;
    for (;;) {
        sum = 0u; cnt = 0u; mine = 0u;
#pragma unroll
        for (unsigned j = 0; j < 16; ++j) { const unsigned c = xb_ld(&bar[XB_XCNT(j)]); sum += c; cnt += (c > 0u) ? 1u : 0u; mine = (j == x) ? c : mine; }
        if (sum == G) break;
        __builtin_amdgcn_s_sleep(1);
        if ((++sp & 255u) == 0u) { if (xb_ld(&bar[XB_TMO])) break; if (sp > XB_SPIN_CAP) { atomicAdd(&bar[XB_TMO], 1u); break; } }
    }
    nloc = mine > 0u ? mine : 1u; nx = cnt > 0u ? cnt : 1u;
}
__device__ __forceinline__ void xcd_barrier(const XcdBarrier& b) {
    asm volatile("s_waitcnt vmcnt(0)" ::: "memory");
    __syncthreads();
    if (MY_TID(b.wave) == 0) {
        unsigned* bar = b.bar;
        __builtin_amdgcn_s_waitcnt(0);
        unsigned nloc = b.st[0], nx = b.st[1];
        if (nloc == 0u) { xcd_barrier_complete(bar, b.x, nloc, nx); b.st[0] = nloc; b.st[1] = nx; }
        const unsigned old = xb_add(&bar[XB_XSUB(b.x)], 1u);
        const unsigned gen = old / nloc;
        if (old + 1u == (gen + 1u) * nloc) {
            __builtin_amdgcn_fence(__ATOMIC_RELEASE, "agent");
            asm volatile("s_waitcnt vmcnt(0)" ::: "memory");
            const unsigned og = xb_add(&bar[XB_TOP], 1u);
            const unsigned tg = og / nx;
            if (og + 1u == (tg + 1u) * nx) xb_add(&bar[XB_TOPGEN], 1u);
            else XB_SPIN(xb_ld(&bar[XB_TOPGEN]) == tg, bar);
            __builtin_amdgcn_fence(__ATOMIC_ACQUIRE, "agent");
            xb_add(&bar[XB_XGEN(b.x)], 1u);
            asm volatile("s_waitcnt vmcnt(0)" ::: "memory");
        } else {
            XB_SPIN(xb_ld(&bar[XB_XGEN(b.x)]) == gen, bar);
            __builtin_amdgcn_fence(__ATOMIC_ACQUIRE, "agent");
            asm volatile("s_waitcnt vmcnt(0)" ::: "memory");
        }
    }
    __syncthreads();
}

enum { MAP_ID = 0, MAP_GU = 1, MAP_DKV = 2, MAP_UQ = 3 };
struct CvtJob { int in_idx; int ldw; int K; int gain_idx; int gain_off; int dst_row0; int nrows; int map; long src_off; long dst_off; };
constexpr int NJOBS = 24;
__device__ const CvtJob JOBS[NJOBS] = {
    {5, 5120, 2048, 3, 0, 0, 5120, MAP_ID, 0L, (long)W_AIN},
    {5, 5120, 2048, 3, 2048, 0, 5120, MAP_ID, 2048L * 5120, (long)(W_AIN + (size_t)5120 * 2048 * 2)},
    {6, 2048, 2048, -1, 0, 0, 2048, MAP_ID, 0L, (long)W_AOUT},
    {6, 2048, 2048, -1, 0, 0, 2048, MAP_ID, 2048L * 2048, (long)(W_AOUT + (size_t)2048 * 2048 * 2)},
    {7, 1024, 2048, 3, 4096, 0, 1024, MAP_ID, 0L, (long)W_BIN},
    {7, 1024, 2048, 3, 6144, 0, 1024, MAP_ID, 2048L * 1024, (long)(W_BIN + (size_t)1792 * 2048 * 2)},
    {14, 576, 2048, 13, 0, 1024, 768, MAP_DKV, 0L, (long)W_BIN},
    {9, 2304, 512, 8, 0, 0, 2304, MAP_UQ, 0L, (long)W_UQ},
    {9, 2304, 512, 8, 512, 0, 2304, MAP_UQ, 512L * 2304, (long)(W_UQ + (size_t)2304 * 512 * 2)},
    {10, 2048, 2048, -1, 0, 0, 2048, MAP_ID, 0L, (long)W_BOUT},
    {10, 2048, 2048, -1, 0, 0, 2048, MAP_ID, 2048L * 2048, (long)(W_BOUT + (size_t)2048 * 2048 * 2)},
    {12, 1024, 2048, -1, 0, 0, 1024, MAP_ID, 0L, (long)W_MEMKV},
    {12, 1024, 2048, -1, 0, 1024, 1024, MAP_ID, 2048L * 1024, (long)W_MEMKV},
    {12, 1024, 2048, -1, 0, 2048, 1024, MAP_ID, 2L * 2048 * 1024, (long)W_MEMKV},
    {12, 1024, 2048, -1, 0, 3072, 1024, MAP_ID, 3L * 2048 * 1024, (long)W_MEMKV},
    {16, 3072, 512, 15, 0, 0, 3072, MAP_ID, 0L, (long)W_UKV},
    {17, 11264, 2048, 4, 0, 0, 11264, MAP_GU, 0L, (long)W_GU},
    {17, 11264, 2048, 4, 2048, 0, 11264, MAP_GU, 2048L * 11264, (long)(W_GU + (size_t)11264 * 2048 * 2)},
    {17, 11264, 2048, 4, 4096, 0, 11264, MAP_GU, 2L * 2048 * 11264, (long)(W_GU + (size_t)2 * 11264 * 2048 * 2)},
    {17, 11264, 2048, 4, 6144, 0, 11264, MAP_GU, 3L * 2048 * 11264, (long)(W_GU + (size_t)3 * 11264 * 2048 * 2)},
    {18, 2048, 5632, -1, 0, 0, 2048, MAP_ID, 0L, (long)W_DN},
    {18, 2048, 5632, -1, 0, 0, 2048, MAP_ID, 5632L * 2048, (long)(W_DN + (size_t)2048 * 5632 * 2)},
    {18, 2048, 5632, -1, 0, 0, 2048, MAP_ID, 2L * 5632 * 2048, (long)(W_DN + (size_t)2 * 2048 * 5632 * 2)},
    {18, 2048, 5632, -1, 0, 0, 2048, MAP_ID, 3L * 5632 * 2048, (long)(W_DN + (size_t)3 * 2048 * 5632 * 2)},
};
__device__ __forceinline__ int ropeperm(int p) { const int t = p >> 3, e = p & 7; return (e < 4) ? 4 * t + e : 32 + 4 * t + (e - 4); }
__device__ __forceinline__ int map_col(int map, int nr) {
    if (map == MAP_ID) return nr;
    if (map == MAP_GU) { const int tile = nr >> 8, j = nr & 255; return (j < 128) ? 128 * tile + j : FFN + 128 * tile + (j - 128); }
    if (map == MAP_DKV) { return (nr < 512) ? nr : ((nr < 576) ? 512 + ropeperm(nr - 512) : -1); }
    const int head = nr / 192, o = nr - head * 192; return (o < 128) ? nr : head * 192 + 128 + ropeperm(o - 128);
}

struct KArgs { const void* in[20]; float* out; unsigned char* ws; int ph_lo, ph_hi; };

__device__ __forceinline__ void cvt_load(const KArgs& A, const CvtJob& J, int item, int lane, f32x4 (&v)[8]) {
    const int nblk = J.nrows / 32, kb = item / nblk, nb = item - kb * nblk, k0 = 64 * kb, n0 = 32 * nb;
    const float* W = (const float*)A.in[J.in_idx] + J.src_off;
    const int col = map_col(J.map, n0 + 4 * (lane & 7));
    const float* wp = W + (size_t)(k0 + (lane >> 3)) * J.ldw + (col >= 0 ? col : 0);
#pragma unroll
    for (int i = 0; i < 8; ++i) v[i] = __builtin_nontemporal_load((const f32x4*)(wp + (size_t)(8 * i) * J.ldw));
}
__device__ __forceinline__ void cvt_store(const KArgs& A, const CvtJob& J, int item, LAS float* scr, int lane, const f32x4 (&v)[8]) {
    const int nblk = J.nrows / 32, kb = item / nblk, nb = item - kb * nblk, k0 = 64 * kb, n0 = 32 * nb;
    const int col = map_col(J.map, n0 + 4 * (lane & 7));
    const int c = lane & 7;
    f32x4 g0 = (f32x4){1.f, 1.f, 1.f, 1.f}, g1 = g0;
    if (J.gain_idx >= 0) { const float* gain = (const float*)A.in[J.gain_idx] + J.gain_off + k0 + 8 * c; g0 = *(const f32x4*)gain; g1 = *(const f32x4*)(gain + 4); }
#pragma unroll
    for (int i = 0; i < 8; ++i)
#pragma unroll
        for (int e = 0; e < 4; ++e) scr[(8 * i + (lane >> 3)) * 33 + 4 * c + e] = (col >= 0) ? v[i][e] : 0.f;
    asm volatile("s_waitcnt lgkmcnt(0)" ::: "memory");
    bf16_t* dst = (bf16_t*)(A.ws + J.dst_off);
#pragma unroll
    for (int j = 0; j < 4; ++j) { const int n = (lane >> 3) + 8 * j; const LAS float* s = scr + (8 * c) * 33 + n;
        u32x4 o; o.x = pk2(s[0 * 33] * g0[0], s[1 * 33] * g0[1]); o.y = pk2(s[2 * 33] * g0[2], s[3 * 33] * g0[3]); o.z = pk2(s[4 * 33] * g1[0], s[5 * 33] * g1[1]); o.w = pk2(s[6 * 33] * g1[2], s[7 * 33] * g1[3]);
        *(u32x4*)(dst + (size_t)(J.dst_row0 + n0 + n) * J.K + k0 + 8 * c) = o; }
    asm volatile("s_waitcnt lgkmcnt(0)" ::: "memory");
}
__device__ __forceinline__ bool cvt_locate(int g, int& jb, int& local) {
    int b = 0;
    for (jb = 0; jb < NJOBS; ++jb) { const int n = (JOBS[jb].nrows / 32) * (JOBS[jb].K / 64); if (g < b + n) { local = g - b; return true; } b += n; }
    return false;
}

struct Ctx { LAS unsigned char* lds; unsigned char* ws; float* out; const float* x; int G, bx, vcu, lo, hi, wave; XcdBarrier bar; };
#define IN(k) (lo <= (k) && (k) < hi)
#define SEAM(k) do { if ((k) + 1 < hi) xcd_barrier(bar); } while (0)
template <int L>
__device__ __forceinline__ void layer_phases(const Ctx& c) {
    LAS unsigned char* lds = c.lds; unsigned char* ws = c.ws; float* out = c.out; const float* x = c.x;
    const int G = c.G, bx = c.bx, vcu = c.vcu, lo = c.lo, hi = c.hi, wave = c.wave; const XcdBarrier bar = c.bar;
    float* SS = (float*)(ws + WS_SS); float* SSQ = (float*)(ws + WS_SSQ); float* SSL = (float*)(ws + WS_SSL);
    float* COS = (float*)(ws + WS_COS); float* SIN = (float*)(ws + WS_SIN);
    bf16_t* HB = (bf16_t*)(ws + WS_HB); bf16_t* KV = (bf16_t*)(ws + WS_KV); bf16_t* KR = (bf16_t*)(ws + WS_KR);
    bf16_t* MEMKV = (bf16_t*)(ws + WS_MEMKV); bf16_t* MEMN = (bf16_t*)(ws + WS_MEMN);
    bf16_t* PROJ = (bf16_t*)(ws + WS_PROJ); bf16_t* PB = (bf16_t*)(ws + WS_PB); bf16_t* QB = (bf16_t*)(ws + WS_Q);
    bf16_t* MIX = (bf16_t*)(ws + WS_MIX); bf16_t* HID = (bf16_t*)(ws + WS_HID);
    {
        constexpr int pb = 1 + 6 * L; constexpr bool isA = L < 2; constexpr int li = L & 1;
        if (IN(pb)) {
            if (L == 0) {
                pg8::Gemm g{MEMN, (const bf16_t*)(ws + W_MEMKV), MROWS, 4096, 2048, 2048, 2048}; pg8::StaticOrder S; S.init(MROWS, 4096, G, bx);
                EpiScaleBf16<0> E{MEMKV, 4096, nullptr};
                pg8::gemm_phase(lds, g, S, E, wave);
            }
            if (isA) {
                pg8::Gemm g{HB, (const bf16_t*)(ws + W_AIN) + (size_t)li * 5120 * 2048, M, A_IN, 2048, 2048, 2048}; pg8::StaticOrder S; S.init(M, A_IN, G, bx);
                EpiScaleBf16<1> E{PROJ, A_IN, SS};
                if (PROBE_NULL_AIN) { EpiNull E0{SSQ}; pg8::gemm_phase(lds, g, S, E0, wave); }
                pg8::gemm_phase(lds, g, S, E, wave);
            } else {
                const int N = (L == 2) ? 1792 : 1024;
                pg8::Gemm g{HB, (const bf16_t*)(ws + W_BIN) + (size_t)li * 1792 * 2048, M, N, 2048, 2048, 2048}; pg8::StaticOrder S; S.init(M, N, G, bx);
                EpiBIn E{PB, KR, SS, SSQ, SSL, COS, SIN};
                pg8::gemm_phase(lds, g, S, E, wave);
            }
            SEAM(pb);
        }
        if (!isA && IN(pb + 1)) {
            { pg8::Gemm g{PB, (const bf16_t*)(ws + W_UQ) + (size_t)li * 2304 * 512, M, UQ_N, 512, PB_LD, 512}; pg8::StaticOrder S; S.init(M, UQ_N, G, bx);
              EpiUq E{QB, SSQ, COS, SIN};
              pg8::gemm_phase(lds, g, S, E, wave); }
            if (L == 2) {
                pg8::Gemm g{PB + 1024, (const bf16_t*)(ws + W_UKV), M, UKV_N, 512, PB_LD, 512}; pg8::StaticOrder S; S.init(M, UKV_N, G, bx);
                EpiScaleBf16<2> E{KV, KVLD, SSL};
                pg8::gemm_phase(lds, g, S, E, wave);
            }
            SEAM(pb + 1);
        }
        if (IN(pb + 2)) {
          for (int rep = 0; rep < PROBE_ATT; ++rep) {
            for (int rep2 = 0; rep2 < PROBE_ATT_MAIN; ++rep2)
            for (int p = vcu; p < BATCH * NH * 4; p += G) {
                const int xx = p & 3, bh = p >> 2, b = bh / NH, h = bh - b * NH;
                for (int half = 0; half < 2; ++half) {
                    const int xq = half ? (7 - xx) : xx;
                    const size_t tok0 = (size_t)b * SEQ, tq = tok0 + (size_t)xq * 256;
                    if (isA) {
                        att::Args a{PROJ + tq * A_IN + h * 128, A_IN, PROJ + tok0 * A_IN + 1536 + h * 128, A_IN, nullptr, 0,
                                    PROJ + tok0 * A_IN + 3072 + h * 128, A_IN, MIX + tq * DM + h * 128, DM, xq * 256, 4 * (xq + 1), wave};
                        att::attn_unit<0, 128>(lds, a);
                    } else {
                        att::Args a{QB + tq * UQ_N + h * 192, UQ_N, KV + tok0 * KVLD + h * 256, KVLD, KR + tok0 * 64, 64,
                                    KV + tok0 * KVLD + h * 256 + 128, KVLD, MIX + tq * DM + h * 128, DM, xq * 256, 4 * (xq + 1), wave};
                        att::attn_unit<1, 192>(lds, a);
                    }
                }
            }
            for (int rep2 = 0; rep2 < PROBE_ATT_MEM; ++rep2)
            for (int p = vcu; p < BATCH * MEMH * 8; p += G) {
                const int xq = p & 7, bh = p >> 3, b = bh >> 2, h = bh & 3;
                const size_t tq = (size_t)b * SEQ + (size_t)xq * 256;
                const bf16_t* Qp = isA ? (PROJ + tq * A_IN + 4608 + h * 128) : (PB + tq * PB_LD + 512 + h * 128);
                const bf16_t* Kp = MEMKV + (size_t)(b * MEML) * 4096 + L * 1024 + h * 128;
                att::Args a{Qp, isA ? A_IN : PB_LD, Kp, 4096, nullptr, 0, Kp + 512, 4096, MIX + tq * DM + 1536 + h * 128, DM, 0, 4, wave};
                att::attn_unit<2, 128>(lds, a);
            }
            __syncthreads();
          }
            SEAM(pb + 2);
        }
        if (IN(pb + 3)) {
            const bf16_t* Wt = (const bf16_t*)(ws + (isA ? W_AOUT : W_BOUT)) + (size_t)li * 2048 * 2048;
            pg8::Gemm g{MIX, Wt, M, DM, 2048, 2048, 2048}; pg8::StaticOrder S; S.init(M, DM, G, bx);
            if (PROBE_NULL_OUT) { EpiNull E0{SSQ}; pg8::gemm_phase(lds, g, S, E0, wave); }
            EpiResid<false, false> E{x, out, HB, SS, (LAS float*)(lds + LDSCTL_OFF + 2048)};
            pg8::gemm_phase(lds, g, S, E, wave);
            SEAM(pb + 3);
        }
        if (IN(pb + 4)) {
            pg8::Gemm g{HB, (const bf16_t*)(ws + W_GU) + (size_t)L * 11264 * 2048, M, 2 * FFN, 2048, 2048, 2048}; pg8::StaticOrder S; S.init(M, 2 * FFN, G, bx);
#if PROBE_SPLIT_GU
            { pg8::Gemm g1 = g; g1.N = FFN; pg8::StaticOrder S1; S1.init(M, FFN, G, bx); EpiSwiglu E1{HID, SS, 0};
              pg8::gemm_phase(lds, g1, S1, E1, wave);
              xcd_barrier(bar);
              pg8::Gemm g2 = g1; g2.Bt = g.Bt + (size_t)FFN * 2048; EpiSwiglu E2{HID, SS, FFN / 2};
              pg8::gemm_phase(lds, g2, S1, E2, wave); }
#else
            EpiSwiglu E{HID, SS, 0};
            pg8::gemm_phase(lds, g, S, E, wave);
            if (PROBE_GU > 1) pg8::gemm_phase(lds, g, S, E, wave);
#endif
            SEAM(pb + 4);
        }
        if (IN(pb + 5)) {
            pg8::Gemm g{HID, (const bf16_t*)(ws + W_DN) + (size_t)L * 2048 * 5632, M, DM, FFN, FFN, FFN}; pg8::StaticOrder S; S.init(M, DM, G, bx);
            if (PROBE_NULL_DN) { EpiNull E0{SSQ}; pg8::gemm_phase(lds, g, S, E0, wave); }
            EpiResid<false, false> E{x, out, HB, SS, (LAS float*)(lds + LDSCTL_OFF + 2048)};
            pg8::gemm_phase(lds, g, S, E, wave);
            SEAM(pb + 5);
        }
    }
}
#undef IN
#undef SEAM
__global__ void __launch_bounds__(512, 2) yoco_fwd(KArgs args) {
    extern __shared__ __attribute__((aligned(16))) unsigned char lds_raw[];
    LAS unsigned char* lds = (LAS unsigned char*)lds_raw;
    volatile LAS unsigned* MISC = (volatile LAS unsigned*)(lds + MISC_OFF);
    const int wave = __builtin_amdgcn_readfirstlane((int)threadIdx.x >> 6);
    const int tid = MY_TID(wave), lane = tid & 63;
    const int G = gridDim.x, bx = blockIdx.x;
    const int vcu = (G % 8 == 0) ? (bx % 8) * (G / 8) + bx / 8 : bx;
    unsigned char* ws = args.ws;
    unsigned* ctl = (unsigned*)(ws + WS_CTL);
    for (int u = tid; u < (LDS_BYTES - LDSCTL_OFF) / 4; u += 512) ((LAS unsigned*)(lds + LDSCTL_OFF))[u] = 0u;
    __syncthreads();
    const int lo = args.ph_lo, hi = args.ph_hi;
    XcdBarrier bar; bar.bar = ctl + CW_BAR; bar.x = 0; bar.st = MISC + 8; bar.wave = wave;
    if (hi - lo > 1) bar = xcd_barrier_post(ctl + CW_BAR, MISC + 8, wave);
#define IN(k) (lo <= (k) && (k) < hi)
#define SEAM(k) do { if ((k) + 1 < hi) xcd_barrier(bar); } while (0)

    const float* x = (const float*)args.in[0];
    float* out = args.out;
    float* SS = (float*)(ws + WS_SS); float* SSQ = (float*)(ws + WS_SSQ); float* SSL = (float*)(ws + WS_SSL);
    float* COS = (float*)(ws + WS_COS); float* SIN = (float*)(ws + WS_SIN);
    bf16_t* HB = (bf16_t*)(ws + WS_HB); bf16_t* KV = (bf16_t*)(ws + WS_KV); bf16_t* KR = (bf16_t*)(ws + WS_KR);
    bf16_t* MEMKV = (bf16_t*)(ws + WS_MEMKV); bf16_t* MEMN = (bf16_t*)(ws + WS_MEMN);
    bf16_t* PROJ = (bf16_t*)(ws + WS_PROJ); bf16_t* PB = (bf16_t*)(ws + WS_PB); bf16_t* QB = (bf16_t*)(ws + WS_Q);
    bf16_t* MIX = (bf16_t*)(ws + WS_MIX); bf16_t* HID = (bf16_t*)(ws + WS_HID);
    const int gw = vcu * 8 + wave, NGW = G * 8;

    if (IN(0)) {
      for (int rep = 0; rep < PROBE_PRO; ++rep) {
        LAS float* scr = (LAS float*)(lds + wave * 16384);
        { f32x4 va[8], vb[8]; int ja = 0, la = 0, jbn = 0, lb = 0;
          int gi = gw; bool ha = cvt_locate(gi, ja, la);
          if (ha) cvt_load(args, JOBS[ja], la, lane, va);
          while (ha) {
              const bool hb = cvt_locate(gi + NGW, jbn, lb);
              if (hb) cvt_load(args, JOBS[jbn], lb, lane, vb);
              cvt_store(args, JOBS[ja], la, scr, lane, va);
              if (!hb) break;
              gi += 2 * NGW; ha = cvt_locate(gi, ja, la);
              if (ha) cvt_load(args, JOBS[ja], la, lane, va);
              cvt_store(args, JOBS[jbn], lb, scr, lane, vb);
          } }
        { f32x4 va[8], vb[8];
          auto ldrow = [&](f32x4 (&v)[8], int m) { const f32x4* xr = (const f32x4*)(x + (size_t)m * DM) + lane;
#pragma unroll
              for (int j = 0; j < 8; ++j) v[j] = __builtin_nontemporal_load(xr + 64 * j); };
          auto strow = [&](const f32x4 (&v)[8], int m) { float s = 0.f;
#pragma unroll
              for (int j = 0; j < 8; ++j) s += sq4(v[j]);
              s = wave_sum(s);
              u32x2* o8 = (u32x2*)(HB + (size_t)m * DM) + lane;
#pragma unroll
              for (int j = 0; j < 8; ++j) { u32x2 w; w.x = pk2(v[j][0], v[j][1]); w.y = pk2(v[j][2], v[j][3]); o8[64 * j] = w; }
              if (lane < 8) SS[(size_t)m * 8 + lane] = (lane == 0) ? s : 0.f; };
          int m = gw; if (m < M) ldrow(va, m);
          while (m < M) {
              const int mn = m + NGW; if (mn < M) ldrow(vb, mn);
              strow(va, m);
              if (mn >= M) break;
              m = mn + NGW; if (m < M) ldrow(va, m);
              strow(vb, mn);
          } }
        { const float* mem = (const float*)args.in[1]; const float* mg = (const float*)args.in[11];
          for (int m = gw; m < MROWS; m += NGW) {
            const f32x4* xr = (const f32x4*)(mem + (size_t)m * DM) + lane; const f32x4* gr = (const f32x4*)mg + lane;
            f32x4 v[8]; float s = 0.f;
#pragma unroll
            for (int j = 0; j < 8; ++j) { v[j] = __builtin_nontemporal_load(xr + 64 * j); s += sq4(v[j]); }
            s = wave_sum(s); const float rstd = rsq(s * (1.0f / 2048.0f) + RMS_EPS);
            u32x2* o8 = (u32x2*)(MEMN + (size_t)m * DM) + lane;
#pragma unroll
            for (int j = 0; j < 8; ++j) { const f32x4 gg = gr[64 * j]; const f32x4 y = v[j] * rstd * gg; u32x2 w; w.x = pk2(y[0], y[1]); w.y = pk2(y[2], y[3]); o8[64 * j] = w; }
          } }
        { const int* pos = (const int*)args.in[2];
          for (int idx = (vcu * 512 + tid); idx < M * 32; idx += G * 512) {
            const int tok = idx >> 5, i = idx & 31;
            const float inv_freq = __builtin_amdgcn_exp2f((float)i * (-13.287712379549449f / 32.0f));
            const float ang = (float)pos[tok] * inv_freq;
            const double rev = (double)ang * 0.15915494309189535;
            const float fr_ = (float)(rev - floor(rev));
            COS[idx] = __builtin_amdgcn_cosf(fr_); SIN[idx] = __builtin_amdgcn_sinf(fr_);
          } }
      }
        SEAM(0);
    }

    { Ctx c{lds, ws, out, x, G, bx, vcu, lo, hi, wave, bar};
      layer_phases<0>(c); layer_phases<1>(c); layer_phases<2>(c); layer_phases<3>(c); }
    if (IN(25)) {
        const float* fg = (const float*)args.in[19];
        int tz = MY_TID(wave); asm volatile("" : "+v"(tz));
        const int lane = tz & 63, gw = vcu * 8 + (tz >> 6);
        { u32x2 wa[8], wb[8]; float sa = 0.f, sb = 0.f;
          auto ldrow = [&](u32x2 (&w)[8], float& s, int m) { s = (lane < 8) ? SS[(size_t)m * 8 + lane] : 0.f;
              const u32x2* hr = (const u32x2*)((const bf16_t*)(ws + WS_HB) + (size_t)m * DM) + lane;
#pragma unroll
              for (int j = 0; j < 8; ++j) w[j] = hr[64 * j]; };
          auto strow = [&](const u32x2 (&w)[8], float s, int m) { s = wave_sum(s); const float rstd = rsq(s * (1.0f / 2048.0f) + RMS_EPS);
              f32x4* xr = (f32x4*)(out + (size_t)m * DM) + lane; const f32x4* gr = (const f32x4*)fg + lane;
#pragma unroll
              for (int j = 0; j < 8; ++j) { const f32x4 v = (f32x4){__uint_as_float(w[j].x << 16), __uint_as_float(w[j].x & 0xffff0000u), __uint_as_float(w[j].y << 16), __uint_as_float(w[j].y & 0xffff0000u)};
                  __builtin_nontemporal_store(v * rstd * gr[64 * j], xr + 64 * j); } };
          int m = gw; if (m < M) ldrow(wa, sa, m);
          while (m < M) {
              const int mn = m + NGW; if (mn < M) ldrow(wb, sb, mn);
              strow(wa, sa, m);
              if (mn >= M) break;
              m = mn + NGW; if (m < M) ldrow(wa, sa, m);
              strow(wb, sb, mn);
          } }
    }
#undef IN
#undef SEAM
}

extern "C" void kernel_launch(void* const* d_in, const int* in_sizes, int n_in, void* d_out, int out_size, void* d_ws, size_t ws_size, hipStream_t stream) {
    static int grid = 0;
    if (grid == 0) {
        if (n_in != 20 || out_size != M * DM || ws_size < WS_END) { fprintf(stderr, "kernel_launch: unexpected shapes (n_in %d out %d ws %zu need %zu)\n", n_in, out_size, ws_size, (size_t)WS_END); grid = -1; return; }
        int dev = 0, cus = 0, per_cu = 0;
        if (hipGetDevice(&dev) != hipSuccess || hipDeviceGetAttribute(&cus, hipDeviceAttributeMultiprocessorCount, dev) != hipSuccess) { grid = -1; return; }
        if (hipFuncSetAttribute((const void*)yoco_fwd, hipFuncAttributeMaxDynamicSharedMemorySize, LDS_BYTES) != hipSuccess) { fprintf(stderr, "kernel_launch: hipFuncSetAttribute failed\n"); grid = -1; return; }
        if (hipOccupancyMaxActiveBlocksPerMultiprocessor(&per_cu, (const void*)yoco_fwd, 512, LDS_BYTES) != hipSuccess || per_cu < 1) { fprintf(stderr, "kernel_launch: occupancy query says %d\n", per_cu); (void)hipGetLastError(); }
        grid = cus;
    }
    if (grid < 0) return;
    (void)hipMemsetAsync((char*)d_ws + WS_CTL, 0, CTL_ZERO_BYTES, stream);
    KArgs a{};
    for (int i = 0; i < 20; ++i) a.in[i] = d_in[i];
    a.out = (float*)d_out; a.ws = (unsigned char*)d_ws;
#if MK_PER_PHASE
    for (int k = 0; k < 26; ++k) {
        if (k >= 1 && k <= 12 && ((k - 1) % 6) == 1) continue;
        a.ph_lo = k; a.ph_hi = k + 1;
        hipLaunchKernelGGL(yoco_fwd, dim3(grid), dim3(512), LDS_BYTES, stream, a);
    }
#else
    a.ph_lo = 0; a.ph_hi = 26;
    hipLaunchKernelGGL(yoco_fwd, dim3(grid), dim3(512), LDS_BYTES, stream, a);
#endif
    const hipError_t le = hipPeekAtLastError();
    if (le != hipSuccess) fprintf(stderr, "kernel_launch: launch failed: %s\n", hipGetErrorName(le));
}
```
